# Optimizing an MI355X kernel written in HIP

```python
import jax
import jax.numpy as jnp
from jax import lax
import numpy as np

D_MODEL = 1024
BATCH = 8
SEQ = 4096
DEPTH = 2

HEAD_DIM = 64
H_A = 4
H_B = 4
H_C = 8
D_MIX = (H_A + H_B + H_C) * HEAD_DIM
IDX_HEADS = 8
IDX_DIM = 64
TOPK_MAX = 256
DILATIONS = ((128, 1), (512, 4), (2048, 16))
Q_BLOCK = 128
D_FF = 2816
N_MOD = 9
IN_COLS = 3 * D_MIX + IDX_HEADS * IDX_DIM + IDX_DIM + IDX_HEADS
EPS = 1e-6

kernel_name = 'hybrid_dsa_stickbreak_dilated_macaron_adaln'


def rms_norm(x, gain):
    xf = x.astype(jnp.float32)
    y = xf * lax.rsqrt(jnp.mean(xf * xf, axis=-1, keepdims=True) + EPS)
    return (y * gain.astype(jnp.float32)).astype(x.dtype)


def modulate(h, shift, scale):
    return h * (1 + scale) + shift


def swiglu(h, w_gate, w_up, w_down):
    g = jnp.einsum('bsd,df->bsf', h, w_gate)
    u = jnp.einsum('bsd,df->bsf', h, w_up)
    return jnp.einsum('bsf,fd->bsd', jax.nn.silu(g) * u, w_down)


def alibi_slopes():
    n = H_A + H_C
    slopes = jnp.exp2(-8.0 * jnp.arange(1, n + 1, dtype=jnp.float32) / n)
    idx = np.arange(n)
    return slopes[idx[idx % 3 == 2]], slopes[idx[idx % 3 != 2]]


def to_blocks(a):
    b, s = a.shape[0], a.shape[1]
    return jnp.moveaxis(a.reshape(b, s // Q_BLOCK, Q_BLOCK, *a.shape[2:]), 1, 0)


def from_blocks(a):
    nb, b = a.shape[0], a.shape[1]
    return jnp.moveaxis(a, 0, 1).reshape(b, nb * Q_BLOCK, *a.shape[3:])


def dsa_attention(q, k, v, qi, ki, wi, slopes, topk):
    s_len = q.shape[1]
    kpos = jnp.arange(s_len)
    scale = HEAD_DIM ** -0.5
    idx_scale = (IDX_DIM ** -0.5) * (IDX_HEADS ** -0.5)

    def block(args):
        qb, qib, wib, t0 = args
        tpos = t0 + jnp.arange(Q_BLOCK)
        rel = jnp.einsum('bthe,bse->bhts', qib, ki).astype(jnp.float32)
        score = jnp.einsum('bth,bhts->bts', wib.astype(jnp.float32), jax.nn.relu(rel)) * idx_scale
        score = jnp.where(kpos[None, None, :] <= tpos[None, :, None], score, -jnp.inf)
        _, sel = lax.top_k(score, topk)
        kg = jax.vmap(lambda kk, ii: kk[ii])(k, sel)
        vg = jax.vmap(lambda vv, ii: vv[ii])(v, sel)
        dist = tpos[None, :, None] - sel
        logits = jnp.einsum('bthd,btkhd->bhtk', qb, kg).astype(jnp.float32) * scale
        logits = logits - slopes[None, :, None, None] * dist[:, None].astype(jnp.float32)
        logits = jnp.where((dist >= 0)[:, None], logits, -jnp.inf)
        p = jax.nn.softmax(logits, axis=-1).astype(v.dtype)
        return jnp.einsum('bhtk,btkhd->bthd', p, vg)

    nb = s_len // Q_BLOCK
    out = lax.map(block, (to_blocks(q), to_blocks(qi), to_blocks(wi), jnp.arange(nb) * Q_BLOCK))
    return from_blocks(out)


def stick_breaking_attention(q, k, v):
    s_len = q.shape[1]
    kpos = jnp.arange(s_len)
    scale = HEAD_DIM ** -0.5

    def block(args):
        qb, t0 = args
        tpos = t0 + jnp.arange(Q_BLOCK)
        z = jnp.einsum('bthd,bshd->bhts', qb, k).astype(jnp.float32) * scale
        strict = kpos[None, :] < tpos[:, None]
        log_1m = jnp.where(strict, jax.nn.log_sigmoid(-z), 0.0)
        log_stay = lax.cumsum(log_1m, axis=3, reverse=True) - log_1m
        a = jnp.where(strict, jnp.exp(jax.nn.log_sigmoid(z) + log_stay), 0.0)
        return jnp.einsum('bhts,bshd->bthd', a.astype(v.dtype), v)

    nb = s_len // Q_BLOCK
    out = lax.map(block, (to_blocks(q), jnp.arange(nb) * Q_BLOCK))
    return from_blocks(out)


def dilated_attention(q, k, v, slopes):
    s_len = q.shape[1]
    scale = HEAD_DIM ** -0.5

    def block(args):
        qb, t0 = args
        tpos = t0 + jnp.arange(Q_BLOCK)
        lses, outs = [], []
        for window, dil in DILATIONS:
            dist = jnp.arange(window // dil + 1) * dil
            kidx = tpos[:, None] - dist[None, :]
            valid = kidx >= 0
            kidx = jnp.maximum(kidx, 0)
            kg = k[:, kidx]
            vg = v[:, kidx]
            logits = jnp.einsum('bthd,btnhd->bhtn', qb, kg).astype(jnp.float32) * scale
            logits = logits - slopes[:, None, None] * dist.astype(jnp.float32)[None, None, :]
            logits = jnp.where(valid[None, None], logits, -jnp.inf)
            m = jnp.max(logits, axis=-1, keepdims=True)
            p = jnp.exp(logits - m)
            l = jnp.sum(p, axis=-1, keepdims=True)
            outs.append(jnp.einsum('bhtn,btnhd->bthd', (p / l).astype(v.dtype), vg))
            lses.append(m + jnp.log(l))
        w = jax.nn.softmax(jnp.stack(lses, axis=0), axis=0)
        w = jnp.transpose(w, (0, 1, 3, 2, 4)).astype(v.dtype)
        return sum(w[i] * outs[i] for i in range(len(DILATIONS)))

    nb = s_len // Q_BLOCK
    out = lax.map(block, (to_blocks(q), jnp.arange(nb) * Q_BLOCK))
    return from_blocks(out)


def token_mixing(h, w_in, qn_a, kn_a, qn_c, kn_c, g_out, w_out, slopes_a, slopes_c):
    b, s_len, _ = h.shape
    topk = min(TOPK_MAX, s_len // 4)
    proj = jnp.einsum('bsd,de->bse', h, w_in)
    sizes = [H_A * HEAD_DIM] * 3 + [IDX_HEADS * IDX_DIM, IDX_DIM, IDX_HEADS] + [H_B * HEAD_DIM] * 3 + [H_C * HEAD_DIM] * 3
    offsets = np.cumsum(sizes)[:-1].tolist()
    qa, ka, va, qi, ki, wi, qb, kb, vb, qc, kc, vc = jnp.split(proj, offsets, axis=-1)
    heads = lambda t, n: t.reshape(b, s_len, n, HEAD_DIM)
    o_a = dsa_attention(rms_norm(heads(qa, H_A), qn_a), rms_norm(heads(ka, H_A), kn_a), heads(va, H_A),
                        qi.reshape(b, s_len, IDX_HEADS, IDX_DIM), ki, wi, slopes_a, topk)
    o_b = stick_breaking_attention(heads(qb, H_B), heads(kb, H_B), heads(vb, H_B))
    o_c = dilated_attention(rms_norm(heads(qc, H_C), qn_c), rms_norm(heads(kc, H_C), kn_c), heads(vc, H_C), slopes_c)
    wa, wb = H_A * HEAD_DIM, H_B * HEAD_DIM
    g_a, g_b, g_c = jnp.split(g_out, [wa, wa + wb])
    y = jnp.concatenate([rms_norm(o_a.reshape(b, s_len, -1), g_a),
                         rms_norm(o_b.reshape(b, s_len, -1), g_b),
                         rms_norm(o_c.reshape(b, s_len, -1), g_c)], axis=-1)
    return jnp.einsum('bse,ed->bsd', y, w_out)


def setup_inputs(seed: int = 0) -> dict:
    key = jax.random.key(seed)
    ks = jax.random.split(key, 24)
    f32 = jnp.float32
    L, D = DEPTH, D_MODEL

    def nrm(k, shape, scale):
        return jax.random.normal(k, shape, f32) * scale

    def gain(k, shape):
        return 1.0 + 0.05 * jax.random.normal(k, shape, f32)

    return {
        'x': nrm(ks[0], (BATCH, SEQ, D), 1.0),
        'c': nrm(ks[1], (BATCH, D), 1.0),
        'w_ada': nrm(ks[2], (L, D, N_MOD * D), 0.5 * D ** -0.5),
        'b_ada': nrm(ks[3], (L, N_MOD * D), 0.02),
        'norm_ffn1': gain(ks[4], (L, D)),
        'w_gate1': nrm(ks[5], (L, D, D_FF), D ** -0.5),
        'w_up1': nrm(ks[6], (L, D, D_FF), D ** -0.5),
        'w_down1': nrm(ks[7], (L, D_FF, D), D_FF ** -0.5),
        'norm_mix': gain(ks[8], (L, D)),
        'w_in': nrm(ks[9], (L, D, IN_COLS), D ** -0.5),
        'qn_a': gain(ks[10], (L, HEAD_DIM)),
        'kn_a': gain(ks[11], (L, HEAD_DIM)),
        'qn_c': gain(ks[12], (L, HEAD_DIM)),
        'kn_c': gain(ks[13], (L, HEAD_DIM)),
        'g_out': gain(ks[14], (L, D_MIX)),
        'w_out': nrm(ks[15], (L, D_MIX, D), D_MIX ** -0.5),
        'norm_ffn2': gain(ks[16], (L, D)),
        'w_gate2': nrm(ks[17], (L, D, D_FF), D ** -0.5),
        'w_up2': nrm(ks[18], (L, D, D_FF), D ** -0.5),
        'w_down2': nrm(ks[19], (L, D_FF, D), D_FF ** -0.5),
    }


def reference(x, c, w_ada, b_ada, norm_ffn1, w_gate1, w_up1, w_down1, norm_mix, w_in, qn_a, kn_a, qn_c, kn_c,
              g_out, w_out, norm_ffn2, w_gate2, w_up2, w_down2):
    slopes_a, slopes_c = alibi_slopes()
    cond = jax.nn.silu(c)
    for l in range(DEPTH):
        mod = jnp.einsum('bd,de->be', cond, w_ada[l]) + b_ada[l]
        sh1, sc1, g1, sh2, sc2, g2, sh3, sc3, g3 = [m[:, None, :] for m in jnp.split(mod, N_MOD, axis=-1)]
        h = modulate(rms_norm(x, norm_ffn1[l]), sh1, sc1)
        x = x + 0.5 * g1 * swiglu(h, w_gate1[l], w_up1[l], w_down1[l])
        h = modulate(rms_norm(x, norm_mix[l]), sh2, sc2)
        x = x + g2 * token_mixing(h, w_in[l], qn_a[l], kn_a[l], qn_c[l], kn_c[l], g_out[l], w_out[l], slopes_a, slopes_c)
        h = modulate(rms_norm(x, norm_ffn2[l]), sh3, sc3)
        x = x + 0.5 * g3 * swiglu(h, w_gate2[l], w_up2[l], w_down2[l])
    return x
```

```cpp
#include <hip/hip_runtime.h>
#include <cstdio>
#include <cstdint>
namespace pg8 {
#define PG8_LAS __attribute__((address_space(3)))
typedef unsigned short bf16_t;
typedef short bf16x8 __attribute__((ext_vector_type(8)));
typedef float f32x4 __attribute__((ext_vector_type(4)));
typedef unsigned u32x4 __attribute__((ext_vector_type(4)));
constexpr int BM = 256, BK = 64, HALF = 128, HTB = HALF * BK * 2  , STAGE_BYTES = 8 * HTB, NXCD = 8, WGM = 8;

__host__ __device__ __forceinline__ int lds_byte(int r, int c) { const int st = (r >> 4) * 2 + (c >> 5), rr = r & 15, cc = c & 31, ob = rr * 64 + cc * 2; return st * 1024 + (ob ^ (((ob >> 9) & 1) << 5)); }
__host__ __device__ __forceinline__ void stage_rc(int b, int& R, int& C) { const int st = b / 1024, sb = b % 1024, swz = sb ^ (((sb >> 9) & 1) << 5); R = (st >> 1) * 16 + swz / 64; C = (st & 1) * 32 + (swz % 64) / 2; }
__host__ __device__ __forceinline__ int perm32(int rho) { const int n = rho >> 4, i = rho & 15; return 8 * (i >> 2) + 4 * n + (i & 3); }

struct Unit { int pm, pn; };
struct Gemm { const bf16_t* A; const bf16_t* Bt; int M, N, K; };

struct StaticOrder {
    int nM, nN, nwg, G, c;
    __host__ __device__ void init(int M, int N, int G_, int c_) { nM = M / BM; nN = N / BM; nwg = nM * nN; G = G_; c = c_; }
    __host__ __device__ bool next(int i, Unit& u) const {
        const long L = (long)i * G + c; if (L >= nwg) return false;
        int wgid = (int)L; { const int q = nwg / NXCD, r = nwg % NXCD, xcd = wgid % NXCD, off = wgid / NXCD; wgid = (xcd < r ? xcd * (q + 1) : r * (q + 1) + (xcd - r) * q) + off; }
        const int nig = WGM * nN, gid = wgid / nig, fm = gid * WGM, gsz = (nM - fm) < WGM ? (nM - fm) : WGM;
        u.pm = fm + ((wgid % nig) % gsz); u.pn = (wgid % nig) / gsz; return true;
    }
    __device__ __forceinline__ void a_ready(const Unit&) const {}
    __device__ __forceinline__ void done(const Unit&) const {}
};

typedef float f32x2 __attribute__((ext_vector_type(2)));
typedef __bf16 bf16x2_t __attribute__((ext_vector_type(2)));
__device__ __forceinline__ unsigned cvt_pk_bf16(float lo, float hi) { f32x2 v = {lo, hi}; bf16x2_t b = __builtin_convertvector(v, bf16x2_t); return __builtin_bit_cast(unsigned, b); }

struct EpiSwiGLU {
    static constexpr bool PERM = true, AFTER_DRAIN = false;
    bf16_t* O; int ldc;
    __device__ __forceinline__ void operator()(const f32x4 (&acc)[2][2][4][2], const Unit& u, int wr, int wc, int fr, int fq) const {
        const int row0 = u.pm * BM + wr * 64 + fr, col0 = u.pn * HALF + wc * 32 + 8 * fq;
#pragma unroll
        for (int ai = 0; ai < 2; ++ai)
#pragma unroll
            for (int m = 0; m < 4; ++m) {
                bf16_t* rowp = O + (size_t)(row0 + ai * HALF + m * 16) * ldc + col0;
                float v[8];
#pragma unroll
                for (int n = 0; n < 2; ++n)
#pragma unroll
                    for (int j = 0; j < 4; ++j) { const float g = acc[ai][0][m][n][j], up = acc[ai][1][m][n][j];
                        const float e = __builtin_amdgcn_exp2f(g * -1.4426950408889634f);
                        v[n * 4 + j] = g * __builtin_amdgcn_rcpf(1.0f + e) * up; }
                u32x4 w; w.x = cvt_pk_bf16(v[0], v[1]); w.y = cvt_pk_bf16(v[2], v[3]); w.z = cvt_pk_bf16(v[4], v[5]); w.w = cvt_pk_bf16(v[6], v[7]);
                *(u32x4*)rowp = w;
            }
    }
};

struct EpiResid {
    static constexpr bool PERM = false, AFTER_DRAIN = false;
    const float* base; float* out; const float* modl; int chunk; float coef;
    __device__ __forceinline__ void operator()(const f32x4 (&acc)[2][2][4][2], const Unit& u, int wr, int wc, int fr, int fq) const {
        const int row0 = u.pm * BM + wr * 64 + fr, col0 = u.pn * BM + wc * 32 + 4 * fq;
        const float* gate = modl + (size_t)(u.pm >> 4) * 9216 + chunk * 1024;
        f32x4 gv[2][2];
#pragma unroll
        for (int bj = 0; bj < 2; ++bj)
#pragma unroll
            for (int n = 0; n < 2; ++n) gv[bj][n] = *(const f32x4*)(gate + col0 + bj * HALF + n * 16) * coef;
#pragma unroll
        for (int ai = 0; ai < 2; ++ai)
#pragma unroll
            for (int m = 0; m < 4; ++m) { const size_t off = (size_t)(row0 + ai * HALF + m * 16) * 1024 + col0;
#pragma unroll
                for (int bj = 0; bj < 2; ++bj)
#pragma unroll
                    for (int n = 0; n < 2; ++n) { const f32x4 bs = *(const f32x4*)(base + off + bj * HALF + n * 16);
                        *(f32x4*)(out + off + bj * HALF + n * 16) = bs + gv[bj][n] * acc[ai][bj][m][n]; }
                if (m & 1) asm volatile("" ::: "memory"); }
    }
};

struct EpiProj {
    static constexpr bool PERM = true, AFTER_DRAIN = false;
    bf16_t* P; int ldc; const float *qn_a, *kn_a, *qn_c, *kn_c; float qscale;
    __device__ __forceinline__ void operator()(const f32x4 (&acc)[2][2][4][2], const Unit& u, int wr, int wc, int fr, int fq) const {
        const int pn = u.pn;
        const float* gain = pn == 0 ? qn_a : pn == 1 ? kn_a : (pn == 6 || pn == 7) ? qn_c : (pn == 8 || pn == 9) ? kn_c : nullptr;
        const float sc = (pn == 0 || pn == 3 || pn == 6 || pn == 7) ? qscale : 1.0f;
        const int row0 = u.pm * BM + wr * 64 + fr, col0 = pn * BM + wc * 64 + 8 * fq;
        f32x4 gv[2][2];
#pragma unroll
        for (int bj = 0; bj < 2; ++bj)
#pragma unroll
            for (int n = 0; n < 2; ++n) gv[bj][n] = gain ? *(const f32x4*)(gain + 32 * bj + 8 * fq + 4 * n) * sc : (f32x4){sc, sc, sc, sc};
#pragma unroll
        for (int ai = 0; ai < 2; ++ai)
#pragma unroll
            for (int m = 0; m < 4; ++m) {
                float rs = 1.0f;
                if (gain) { float ss = 0.f;
#pragma unroll
                    for (int bj = 0; bj < 2; ++bj)
#pragma unroll
                        for (int n = 0; n < 2; ++n) { const f32x4 x = acc[ai][bj][m][n]; ss += (x[0] * x[0] + x[1] * x[1]) + (x[2] * x[2] + x[3] * x[3]); }
                    ss += __shfl_xor(ss, 16); ss += __shfl_xor(ss, 32);
                    rs = __builtin_amdgcn_rsqf(ss * (1.0f / 64.0f) + 1e-6f); }
                bf16_t* rowp = P + (size_t)(row0 + ai * HALF + m * 16) * ldc + col0;
#pragma unroll
                for (int bj = 0; bj < 2; ++bj) { const f32x4 v0 = acc[ai][bj][m][0] * gv[bj][0] * rs, v1 = acc[ai][bj][m][1] * gv[bj][1] * rs;
                    u32x4 w; w.x = cvt_pk_bf16(v0[0], v0[1]); w.y = cvt_pk_bf16(v0[2], v0[3]); w.z = cvt_pk_bf16(v1[0], v1[1]); w.w = cvt_pk_bf16(v1[2], v1[3]);
                    *(u32x4*)(rowp + 32 * bj) = w; }
            }
    }
};

template <class Epi, class Sched, bool ALIGN_EPI = false, bool SP2 = false>
__device__ __forceinline__ void gemm_phase(PG8_LAS unsigned char* lds, const Gemm g, const Sched& S, const Epi& E) {
    int tid_o = threadIdx.x; asm volatile("" : "+v"(tid_o));
    const int tid = tid_o, wid = __builtin_amdgcn_readfirstlane(tid >> 6), lane = tid & 63, wr = wid >> 2, wc = wid & 3, fr = lane & 15, fq = lane >> 4;
    const int K = g.K, nt = K / BK;
    unsigned voffA[2], voffB[2];
#pragma unroll
    for (int i = 0; i < 2; ++i) { int R, C; stage_rc(tid * 16 + i * 8192, R, C); const int Rb = Epi::PERM ? ((R & ~31) + perm32(R & 31)) : R;
        voffA[i] = (unsigned)(R * K + C) * 2u; voffB[i] = (unsigned)(Rb * K + C) * 2u; }
    const size_t kstep = (size_t)(BK * 2);
    const size_t hstep = (size_t)HALF * K * 2;
    const size_t tstep = 2 * hstep;
    const unsigned ldsw = (unsigned)wid * 1024u;
    const int aoff = lds_byte(wr * 64 + fr, fq * 8), boff = lds_byte(wc * 32 + fr, fq * 8);
#define PG8_SA(b, h) (((b) * 2 + (h)) * HTB)
#define PG8_SB(b, h) ((4 + (b) * 2 + (h)) * HTB)
#define PG8_STAGE(bufoff, gbase, voff) do { _Pragma("unroll") for (int _i = 0; _i < 2; ++_i) \
        __builtin_amdgcn_global_load_lds((const unsigned*)((const char*)(gbase) + (voff)[_i]), (PG8_LAS unsigned*)(lds + (bufoff) + ldsw + _i * 8192), 16, 0, 0); } while (0)
#define PG8_LDA(dst, b, h) do { _Pragma("unroll") for (int m = 0; m < 4; ++m) _Pragma("unroll") for (int k = 0; k < 2; ++k) dst[m][k] = *(const PG8_LAS bf16x8*)(lds + PG8_SA(b, h) + aoff + m * 2048 + k * 1024); } while (0)
#define PG8_LDB(dst, b, h) do { _Pragma("unroll") for (int n = 0; n < 2; ++n) _Pragma("unroll") for (int k = 0; k < 2; ++k) dst[n][k] = *(const PG8_LAS bf16x8*)(lds + PG8_SB(b, h) + boff + n * 2048 + k * 1024); } while (0)
#define PG8_MMA(ai, bj, At, Bt) do { __builtin_amdgcn_s_setprio(1); _Pragma("unroll") for (int m = 0; m < 4; ++m) _Pragma("unroll") for (int n = 0; n < 2; ++n) _Pragma("unroll") for (int k = 0; k < 2; ++k) \
        acc[ai][bj][m][n] = __builtin_amdgcn_mfma_f32_16x16x32_bf16(Bt[n][k], At[m][k], acc[ai][bj][m][n], 0, 0, 0); __builtin_amdgcn_s_setprio(0); } while (0)
#define PG8_WAIT_V(n) asm volatile("s_waitcnt vmcnt(" #n ")" ::: "memory")
#define PG8_WAIT_L(n) asm volatile("s_waitcnt lgkmcnt(" #n ")" ::: "memory")
#define PG8_BAR __builtin_amdgcn_s_barrier()
#define PG8_SCHED __builtin_amdgcn_sched_barrier(0)
    Unit cur, nxt; int ui = 0;
    if (!S.next(0, cur)) return;
    f32x4 acc[2][2][4][2];
#pragma unroll
    for (int a = 0; a < 2; ++a)
#pragma unroll
        for (int b = 0; b < 2; ++b)
#pragma unroll
            for (int m = 0; m < 4; ++m)
#pragma unroll
                for (int n = 0; n < 2; ++n) acc[a][b][m][n] = (f32x4){0.f, 0.f, 0.f, 0.f};
    bf16x8 At[4][2], B0[2][2], B1[2][2];
    const char* cA = (const char*)g.A + (size_t)cur.pm * tstep; const char* cB = (const char*)g.Bt + (size_t)cur.pn * tstep;
    S.a_ready(cur);
    if constexpr (SP2) {
        PG8_STAGE(PG8_SB(0, 0), cB, voffB); PG8_STAGE(PG8_SB(0, 1), cB + hstep, voffB); PG8_STAGE(PG8_SA(0, 0), cA, voffA); PG8_STAGE(PG8_SA(0, 1), cA + hstep, voffA);
        if (wr == 1) PG8_BAR;
        PG8_WAIT_V(2); PG8_BAR;
        PG8_STAGE(PG8_SB(1, 0), cB + kstep, voffB); PG8_STAGE(PG8_SA(1, 0), cA + kstep, voffA); PG8_STAGE(PG8_SB(1, 1), cB + hstep + kstep, voffB);
        PG8_WAIT_V(6); PG8_BAR;
    } else {
        PG8_STAGE(PG8_SB(0, 0), cB, voffB); PG8_STAGE(PG8_SA(0, 0), cA, voffA); PG8_STAGE(PG8_SB(0, 1), cB + hstep, voffB); PG8_STAGE(PG8_SA(0, 1), cA + hstep, voffA);
        if (wr == 1) PG8_BAR;
        PG8_WAIT_V(4); PG8_BAR;
        PG8_STAGE(PG8_SB(1, 0), cB + kstep, voffB); PG8_STAGE(PG8_SA(1, 0), cA + kstep, voffA); PG8_STAGE(PG8_SB(1, 1), cB + hstep + kstep, voffB);
        PG8_WAIT_V(6); PG8_BAR;
    }
    for (;;) {
        const bool has_next = S.next(ui + 1, nxt);
        const char* nA = has_next ? (const char*)g.A + (size_t)nxt.pm * tstep : cA; const char* nB = has_next ? (const char*)g.Bt + (size_t)nxt.pn * tstep : cB;
        for (int t = 0; t < nt; t += 2) {
            const bool last = (t == nt - 2);
            const char* a1 = cA + (size_t)(t + 1) * kstep;
            const char* a2 = last ? nA : cA + (size_t)(t + 2) * kstep; const char* b2 = last ? nB : cB + (size_t)(t + 2) * kstep;
            const char* a3 = a2 + kstep; const char* b3 = b2 + kstep;
            if (last && has_next) S.a_ready(nxt);
            if constexpr (SP2) {
            PG8_LDB(B0, 0, 0); PG8_LDB(B1, 0, 1); PG8_SCHED; PG8_LDA(At, 0, 0); PG8_STAGE(PG8_SA(1, 1), a1 + hstep, voffA);
            PG8_WAIT_V(8); PG8_WAIT_L(0); PG8_BAR; PG8_MMA(0, 0, At, B0); PG8_MMA(0, 1, At, B1); PG8_BAR; PG8_SCHED;
            PG8_LDA(At, 0, 1); PG8_STAGE(PG8_SB(0, 0), b2, voffB); PG8_STAGE(PG8_SB(0, 1), b2 + hstep, voffB); PG8_STAGE(PG8_SA(0, 0), a2, voffA);
            PG8_WAIT_V(8); PG8_WAIT_L(0); PG8_BAR; PG8_MMA(1, 0, At, B0); PG8_MMA(1, 1, At, B1); PG8_BAR; PG8_SCHED;
            PG8_LDB(B0, 1, 0); PG8_LDB(B1, 1, 1); PG8_SCHED; PG8_LDA(At, 1, 0); PG8_STAGE(PG8_SA(0, 1), a2 + hstep, voffA);
            PG8_WAIT_V(8); PG8_WAIT_L(0); PG8_BAR; PG8_MMA(0, 0, At, B0); PG8_MMA(0, 1, At, B1); PG8_BAR; PG8_SCHED;
            PG8_LDA(At, 1, 1); PG8_STAGE(PG8_SB(1, 0), b3, voffB); PG8_STAGE(PG8_SB(1, 1), b3 + hstep, voffB); PG8_STAGE(PG8_SA(1, 0), a3, voffA);
            PG8_WAIT_V(8); PG8_WAIT_L(0); PG8_BAR; PG8_MMA(1, 0, At, B0); PG8_MMA(1, 1, At, B1); PG8_BAR; PG8_SCHED;
            } else {
            PG8_LDB(B0, 0, 0); PG8_SCHED; PG8_LDA(At, 0, 0); PG8_STAGE(PG8_SA(1, 1), a1 + hstep, voffA);
            PG8_WAIT_L(8); PG8_BAR; PG8_WAIT_L(0); PG8_MMA(0, 0, At, B0); PG8_BAR; PG8_SCHED;
            PG8_LDB(B1, 0, 1); PG8_STAGE(PG8_SB(0, 0), b2, voffB);
            PG8_BAR; PG8_WAIT_L(0); PG8_MMA(0, 1, At, B1); PG8_BAR;
            PG8_LDA(At, 0, 1); PG8_STAGE(PG8_SA(0, 0), a2, voffA);
            PG8_BAR; PG8_WAIT_L(0); PG8_MMA(1, 0, At, B0); PG8_BAR; PG8_SCHED;
            PG8_STAGE(PG8_SB(0, 1), b2 + hstep, voffB);
            PG8_WAIT_V(6); PG8_BAR; PG8_MMA(1, 1, At, B1); PG8_BAR;
            PG8_LDB(B0, 1, 0); PG8_SCHED; PG8_LDA(At, 1, 0); PG8_STAGE(PG8_SA(0, 1), a2 + hstep, voffA);
            PG8_WAIT_L(8); PG8_BAR; PG8_WAIT_L(0); PG8_MMA(0, 0, At, B0); PG8_BAR; PG8_SCHED;
            PG8_LDB(B1, 1, 1); PG8_STAGE(PG8_SB(1, 0), b3, voffB);
            PG8_BAR; PG8_WAIT_L(0); PG8_MMA(0, 1, At, B1); PG8_BAR;
            PG8_LDA(At, 1, 1); PG8_STAGE(PG8_SA(1, 0), a3, voffA);
            PG8_BAR; PG8_WAIT_L(0); PG8_MMA(1, 0, At, B0); PG8_BAR; PG8_SCHED;
            PG8_STAGE(PG8_SB(1, 1), b3 + hstep, voffB);
            PG8_WAIT_V(6); PG8_BAR; PG8_MMA(1, 1, At, B1); PG8_BAR;
            }
        }
        if constexpr (ALIGN_EPI) { if (wr == 0) PG8_BAR; }
        if constexpr (!Epi::AFTER_DRAIN) { E(acc, cur, wr, wc, fr, fq); S.done(cur); }
        if (!has_next) break;
#pragma unroll
        for (int a = 0; a < 2; ++a)
#pragma unroll
            for (int b = 0; b < 2; ++b)
#pragma unroll
                for (int m = 0; m < 4; ++m)
#pragma unroll
                    for (int n = 0; n < 2; ++n) acc[a][b][m][n] = (f32x4){0.f, 0.f, 0.f, 0.f};
        cur = nxt; cA = nA; cB = nB; ++ui;
        if constexpr (ALIGN_EPI) { if (wr == 1) PG8_BAR; }
    }
    PG8_WAIT_V(0);
    if constexpr (!ALIGN_EPI) { if (wr == 0) PG8_BAR; }
    PG8_BAR;
    if constexpr (Epi::AFTER_DRAIN) { E.fused(acc, cur, wr, wc, fr, fq, lds, wid, lane); S.done(cur); }
#undef PG8_SA
#undef PG8_SB
#undef PG8_STAGE
#undef PG8_LDA
#undef PG8_LDB
#undef PG8_MMA
#undef PG8_WAIT_V
#undef PG8_WAIT_L
#undef PG8_BAR
#undef PG8_SCHED
}
}

constexpr int NB = 8, SEQ = 4096, DM = 1024, MTOK = NB * SEQ, DFF = 2816, NGU = 2 * DFF, NPROJ = 3840, NMODC = 9 * DM, WIN_COLS = 3656;
constexpr float LOG2E = 1.4426950408889634f, QSCALE = 0.125f * 1.4426950408889634f;
constexpr int PC_QA = 0, PC_KA = 256, PC_VA = 512, PC_QB = 768, PC_KB = 1024, PC_VB = 1280, PC_QC = 1536, PC_KC = 2048, PC_VC = 2560, PC_QI = 3072, PC_KI = 3584, PC_WI = 3648;
constexpr int NWAVES = 8;

constexpr size_t MiB = 1u << 20;
constexpr size_t WS_CTL = 0, CTL_ZERO_BYTES = 1 * MiB;
constexpr size_t WS_MOD = 2 * MiB;
constexpr size_t WS_W = 4 * MiB;
constexpr size_t OFF_WGU1 = 0, OFF_WD1 = OFF_WGU1 + (size_t)NGU * DM * 2, OFF_WGU2 = OFF_WD1 + (size_t)DM * DFF * 2, OFF_WD2 = OFF_WGU2 + (size_t)NGU * DM * 2,
                 OFF_WIN = OFF_WD2 + (size_t)DM * DFF * 2, OFF_WOUT = OFF_WIN + (size_t)NPROJ * DM * 2, LAYER_W_BYTES = OFF_WOUT + (size_t)DM * DM * 2;
constexpr size_t WS_H = 96 * MiB;
constexpr size_t WS_PROJ = 160 * MiB;
constexpr size_t WS_O = 400 * MiB;
constexpr size_t WS_MASK = 464 * MiB;
constexpr size_t WS_END = 480 * MiB;
static_assert(WS_W + 2 * LAYER_W_BYTES <= WS_H && WS_PROJ + (size_t)MTOK * NPROJ * 2 <= WS_O && WS_MASK + (size_t)NB * 64 * SEQ * 8 <= WS_END, "d_ws map");
constexpr int CW_BAR = 4096;
constexpr int RING_BYTES = 131072, EXTRA_OFF = RING_BYTES, LDSCTL_OFF = EXTRA_OFF + 4096, MISC_OFF = LDSCTL_OFF + 320, LDS_BYTES = 147456;

#define GAS __attribute__((address_space(1)))
#define LAS __attribute__((address_space(3)))
typedef unsigned short bf16;
typedef unsigned v4u __attribute__((ext_vector_type(4)));
typedef unsigned v2u __attribute__((ext_vector_type(2)));
typedef float f32x4 __attribute__((ext_vector_type(4)));
typedef short bf16x8 __attribute__((ext_vector_type(8)));
typedef GAS unsigned gu32;
#define LDS_WAIT() asm volatile("s_waitcnt lgkmcnt(0)" ::: "memory")
#define VM_WAIT() asm volatile("s_waitcnt vmcnt(0)" ::: "memory")
__device__ __forceinline__ unsigned pk2(float lo, float hi) { return pg8::cvt_pk_bf16(lo, hi); }
__device__ __forceinline__ float bf2f(bf16 v) { return __uint_as_float((unsigned)v << 16); }
#define XB_TMO      128
#define XB_XCNT(j)  (256  + 64 * (j))
#define XB_XSUB(j)  (1280 + 64 * (j))
#define XB_XGEN(j)  (2304 + 64 * (j))
#define XB_TOP      3328
#define XB_TOPGEN   3392
#define XCD_BAR_WORDS 3456
#define XB_SPIN_CAP (1u << 18)

__device__ __forceinline__ unsigned xb_ld(unsigned* p)              { return __hip_atomic_load(p, __ATOMIC_RELAXED, __HIP_MEMORY_SCOPE_AGENT); }
__device__ __forceinline__ unsigned xb_add(unsigned* p, unsigned v) { return __hip_atomic_fetch_add(p, v, __ATOMIC_RELAXED, __HIP_MEMORY_SCOPE_AGENT); }
__device__ __forceinline__ unsigned xb_xcc_id() { return (unsigned)__builtin_amdgcn_s_getreg((3 << 11) | 20) & 0xFu; }
#define XB_SPIN(cond, bar) do { unsigned _sp = 0; while (cond) { __builtin_amdgcn_s_sleep(1); \
    if ((++_sp & 255u) == 0u) { if (xb_ld(&(bar)[XB_TMO])) break; if (_sp > XB_SPIN_CAP) { atomicAdd(&(bar)[XB_TMO], 1u); break; } } } } while (0)

struct XcdBarrier {
    unsigned* bar; unsigned x;
    volatile LAS unsigned* st;
};

__device__ __forceinline__ XcdBarrier xcd_barrier_post(unsigned* bar, volatile LAS unsigned* st) {
    XcdBarrier b; b.bar = bar; b.x = xb_xcc_id(); b.st = st;
    if (threadIdx.x == 0) (void)xb_add(&bar[XB_XCNT(b.x)], 1u);
    return b;
}
__device__ __forceinline__ void xcd_barrier_complete(unsigned* bar, unsigned x, unsigned& nloc, unsigned& nx) {
    const unsigned G = gridDim.x * gridDim.y * gridDim.z;
    unsigned sum, cnt, mine, sp = 0u;
    for (;;) {
        sum = 0u; cnt = 0u; mine = 0u;
#pragma unroll
        for (unsigned j = 0; j < 16; ++j) { const unsigned c = xb_ld(&bar[XB_XCNT(j)]); sum += c; cnt += (c > 0u) ? 1u : 0u; mine = (j == x) ? c : mine; }
        if (sum == G) break;
        __builtin_amdgcn_s_sleep(1);
        if ((++sp & 255u) == 0u) { if (xb_ld(&bar[XB_TMO])) break; if (sp > XB_SPIN_CAP) { atomicAdd(&bar[XB_TMO], 1u); break; } }
    }
    nloc = mine > 0u ? mine : 1u; nx = cnt > 0u ? cnt : 1u;
}

__device__ __forceinline__ void xcd_barrier(const XcdBarrier& b) {
    asm volatile("s_waitcnt vmcnt(0)" ::: "memory");
    __syncthreads();
    if (threadIdx.x == 0) {
        unsigned* bar = b.bar;
        __builtin_amdgcn_s_waitcnt(0);
        unsigned nloc = b.st[0], nx = b.st[1];
        if (nloc == 0u) { xcd_barrier_complete(bar, b.x, nloc, nx); b.st[0] = nloc; b.st[1] = nx; }
        const unsigned old = xb_add(&bar[XB_XSUB(b.x)], 1u);
        const unsigned gen = old / nloc;
        if (old + 1u == (gen + 1u) * nloc) {
            __builtin_amdgcn_fence(__ATOMIC_RELEASE, "agent");
            asm volatile("s_waitcnt vmcnt(0)" ::: "memory");
            const unsigned og = xb_add(&bar[XB_TOP], 1u);
            const unsigned tg = og / nx;
            if (og + 1u == (tg + 1u) * nx) xb_add(&bar[XB_TOPGEN], 1u);
            else XB_SPIN(xb_ld(&bar[XB_TOPGEN]) == tg, bar);
            __builtin_amdgcn_fence(__ATOMIC_ACQUIRE, "agent");
            xb_add(&bar[XB_XGEN(b.x)], 1u);
            asm volatile("s_waitcnt vmcnt(0)" ::: "memory");
        } else {
            XB_SPIN(xb_ld(&bar[XB_XGEN(b.x)]) == gen, bar);
            __builtin_amdgcn_fence(__ATOMIC_ACQUIRE, "agent");
            asm volatile("s_waitcnt vmcnt(0)" ::: "memory");
        }
    }
    __syncthreads();
}

struct Frame {
    LAS unsigned char* lds;
    int tid, lane, wave;
    int vcu, G;
};
__device__ __forceinline__ float wave_sum(float v) {
#pragma unroll
    for (int o = 1; o < 64; o <<= 1) v += __shfl_xor(v, o);
    return v;
}

__device__ __forceinline__ void transpose_item(const float* W, int ldw, int c0, int ncols, int K, int kb, bf16* WT, int dst_row0, const float* kscale, LAS float* scr, int lane) {
    const int k0 = 64 * kb, n = lane & 31;
#pragma unroll 8
    for (int i = 0; i < 32; ++i) { const int kk = 2 * i + (lane >> 5);
        float v = 0.f;
        if (n < ncols) { v = W[(size_t)(k0 + kk) * ldw + c0 + n]; if (kscale) v *= kscale[k0 + kk]; }
        scr[kk * 33 + n] = v; }
    LDS_WAIT(); asm volatile("" ::: "memory");
    const int c = lane & 7;
#pragma unroll
    for (int j = 0; j < 4; ++j) { const int nn = (lane >> 3) + 8 * j; const LAS float* s = scr + (8 * c) * 33 + nn;
        v4u o; o.x = pk2(s[0 * 33], s[1 * 33]); o.y = pk2(s[2 * 33], s[3 * 33]); o.z = pk2(s[4 * 33], s[5 * 33]); o.w = pk2(s[6 * 33], s[7 * 33]);
        *(GAS v4u*)(WT + (size_t)(dst_row0 + nn) * K + k0 + 8 * c) = o; }
    LDS_WAIT(); asm volatile("" ::: "memory");
}
struct Ptrs {
    const float *x, *c, *w_ada, *b_ada, *norm_ffn1, *w_gate1, *w_up1, *w_down1, *norm_mix, *w_in, *qn_a, *kn_a, *qn_c, *kn_c, *g_out, *w_out, *norm_ffn2, *w_gate2, *w_up2, *w_down2;
    float* out; unsigned char* ws; int ph_lo, ph_hi;
};
constexpr int IT_GU = (NGU / 32) * (DM / 64), IT_D = (DM / 32) * (DFF / 64), IT_IN = (NPROJ / 32) * (DM / 64), IT_OUT = (DM / 32) * (DM / 64);
constexpr int IT_LAYER = 2 * IT_GU + 2 * IT_D + IT_IN + IT_OUT;
__device__ __forceinline__ void p0_prologue(Frame& F, const Ptrs& P) {
    {
        LAS float* sl = (LAS float*)F.lds;
        LAS float* part = (LAS float*)(F.lds + 32768);
        float* mod = (float*)(P.ws + WS_MOD);
        for (int it = blockIdx.x; it < 72; it += F.G) {
            const int l = it / 36, cb = it % 36;
            for (int i = F.tid; i < NB * DM; i += NWAVES * 64) { const float cv = P.c[i]; sl[i] = cv / (1.0f + __expf(-cv)); }
            __syncthreads();
            f32x4 acc[NB];
#pragma unroll
            for (int b = 0; b < NB; ++b) acc[b] = (f32x4){0.f, 0.f, 0.f, 0.f};
            const float* wp = P.w_ada + (size_t)l * DM * NMODC + 256 * cb + 4 * F.lane;
#pragma unroll 4
            for (int kk = 0; kk < 128; ++kk) { const int k = 128 * F.wave + kk; const f32x4 wv = *(const GAS f32x4*)(wp + (size_t)k * NMODC);
#pragma unroll
                for (int b = 0; b < NB; ++b) acc[b] += wv * sl[b * DM + k]; }
#pragma unroll
            for (int b = 0; b < NB; ++b) *(LAS f32x4*)(part + (F.wave * NB + b) * 256 + 4 * F.lane) = acc[b];
            __syncthreads();
            for (int o = F.tid; o < NB * 256; o += NWAVES * 64) { const int b = o >> 8, col = o & 255; float s = P.b_ada[l * NMODC + 256 * cb + col];
#pragma unroll
                for (int w = 0; w < NWAVES; ++w) s += part[(w * NB + b) * 256 + col];
                mod[(size_t)(l * NB + b) * NMODC + 256 * cb + col] = s; }
            __syncthreads();
        }
    }
    LAS float* scr = (LAS float*)(F.lds + F.wave * 16384);
    const int gw = F.vcu * NWAVES + F.wave, NGW = F.G * NWAVES;
    for (int it0 = gw; it0 < 2 * IT_LAYER; it0 += NGW) {
        const int l = it0 / IT_LAYER; int it = it0 % IT_LAYER;
        unsigned char* wl = P.ws + WS_W + (size_t)l * LAYER_W_BYTES;
        if (it < 2 * (IT_GU + IT_D)) {
            const int f2 = it >= (IT_GU + IT_D); if (f2) it -= IT_GU + IT_D;
            const float* wg = (f2 ? P.w_gate2 : P.w_gate1) + (size_t)l * DM * DFF; const float* wu = (f2 ? P.w_up2 : P.w_up1) + (size_t)l * DM * DFF;
            const float* wd = (f2 ? P.w_down2 : P.w_down1) + (size_t)l * DFF * DM;
            if (it < IT_GU) { const int g = it / (DM / 64), kb = it % (DM / 64), pn = g >> 3, sub = g & 7;
                transpose_item(sub < 4 ? wg : wu, DFF, 128 * pn + 32 * (sub & 3), 32, DM, kb, (bf16*)(wl + (f2 ? OFF_WGU2 : OFF_WGU1)), 32 * g, nullptr, scr, F.lane); }
            else { it -= IT_GU; const int g = it / (DFF / 64), kb = it % (DFF / 64);
                transpose_item(wd, DM, 32 * g, 32, DFF, kb, (bf16*)(wl + (f2 ? OFF_WD2 : OFF_WD1)), 32 * g, nullptr, scr, F.lane); }
            continue;
        }
        it -= 2 * (IT_GU + IT_D);
        if (it < IT_IN) { const int g = it / (DM / 64), kb = it % (DM / 64), pn = g >> 3, sub = g & 7, bj = sub >> 2, wc = sub & 3, pc0 = 256 * pn + 64 * wc + 32 * bj;
            int c0 = 0, nc = 32;
            if (pc0 < 768) c0 = pc0; else if (pc0 < 1536) c0 = pc0 - 768 + 1352; else if (pc0 < 3072) c0 = pc0 - 1536 + 2120; else if (pc0 < 3584) c0 = pc0 - 3072 + 768;
            else if (pc0 < 3648) c0 = pc0 - 3584 + 1280; else if (pc0 == 3648) { c0 = 1344; nc = 8; } else nc = 0;
            transpose_item(P.w_in + (size_t)l * DM * WIN_COLS, WIN_COLS, c0, nc, DM, kb, (bf16*)(wl + OFF_WIN), 32 * g, nullptr, scr, F.lane);
            continue; }
        it -= IT_IN;
        { const int g = it / (DM / 64), kb = it % (DM / 64);
          transpose_item(P.w_out + (size_t)l * DM * DM, DM, 32 * g, 32, DM, kb, (bf16*)(wl + OFF_WOUT), 32 * g, P.g_out + l * DM, scr, F.lane); }
    }
}

__device__ __forceinline__ void norm_mod_phase(Frame& F, const float* xsrc, const float* gain, const float* modl, int ch_shift, int ch_scale, bf16* hout) {
    for (int rb = blockIdx.x; rb < MTOK / 128; rb += F.G) {
        const int b = rb >> 5;
        const float* shp = modl + (size_t)b * NMODC + ch_shift * DM; const float* scp = modl + (size_t)b * NMODC + ch_scale * DM;
        f32x4 ga[4], sh[4];
#pragma unroll
        for (int j = 0; j < 4; ++j) { const int col = 4 * F.lane + 256 * j; const f32x4 g = *(const GAS f32x4*)(gain + col), s = *(const GAS f32x4*)(scp + col);
            ga[j] = g * (s + 1.0f); sh[j] = *(const GAS f32x4*)(shp + col); }
        for (int rr = 0; rr < 16; ++rr) { const int row = 128 * rb + 16 * F.wave + rr;
            const GAS f32x4* xr = (const GAS f32x4*)(xsrc + (size_t)row * DM) + F.lane;
            f32x4 v[4]; float ss = 0.f;
#pragma unroll
            for (int j = 0; j < 4; ++j) { v[j] = xr[64 * j]; ss += (v[j].x * v[j].x + v[j].y * v[j].y) + (v[j].z * v[j].z + v[j].w * v[j].w); }
            const float rstd = 1.0f / sqrtf(wave_sum(ss) * (1.0f / DM) + 1e-6f);
            GAS v2u* o8 = (GAS v2u*)(hout + (size_t)row * DM) + F.lane;
#pragma unroll
            for (int j = 0; j < 4; ++j) { const f32x4 y = v[j] * rstd * ga[j] + sh[j]; v2u w; w.x = pk2(y.x, y.y); w.y = pk2(y.z, y.w); o8[64 * j] = w; }
        }
    }
}
__device__ __forceinline__ void group_norm_phase(Frame& F, const bf16* o, bf16* y) {
    const int gw = blockIdx.x * NWAVES + F.wave, NGW = F.G * NWAVES;
    for (int row = gw; row < MTOK; row += NGW) {
        const GAS v2u* orow = (const GAS v2u*)(o + (size_t)row * DM) + F.lane;
        float v[4][4], ss[4];
#pragma unroll
        for (int j = 0; j < 4; ++j) { const v2u w = orow[64 * j]; v[j][0] = __uint_as_float(w.x << 16); v[j][1] = __uint_as_float(w.x & 0xffff0000u); v[j][2] = __uint_as_float(w.y << 16); v[j][3] = __uint_as_float(w.y & 0xffff0000u);
            ss[j] = wave_sum((v[j][0] * v[j][0] + v[j][1] * v[j][1]) + (v[j][2] * v[j][2] + v[j][3] * v[j][3])); }
        float rs[4];
        rs[0] = 1.0f / sqrtf(ss[0] * (1.0f / 256.f) + 1e-6f); rs[1] = 1.0f / sqrtf(ss[1] * (1.0f / 256.f) + 1e-6f); rs[2] = rs[3] = 1.0f / sqrtf((ss[2] + ss[3]) * (1.0f / 512.f) + 1e-6f);
        GAS v2u* yrow = (GAS v2u*)(y + (size_t)row * DM) + F.lane;
#pragma unroll
        for (int j = 0; j < 4; ++j) { v2u w; w.x = pk2(v[j][0] * rs[j], v[j][1] * rs[j]); w.y = pk2(v[j][2] * rs[j], v[j][3] * rs[j]); yrow[64 * j] = w; }
    }
}

namespace att {
typedef float f32x16 __attribute__((ext_vector_type(16)));
typedef short s16x4 __attribute__((ext_vector_type(4)));
__device__ __forceinline__ int crow(int r, int hi) { return (r & 3) + 8 * (r >> 2) + 4 * hi; }
#define SBAR() __builtin_amdgcn_sched_barrier(0)
__device__ __forceinline__ void pv(f32x16* o, int vb, bf16x8 pa0, bf16x8 pa1, bf16x8 pa2, bf16x8 pa3) {
#pragma unroll
    for (int d0 = 0; d0 < 2; ++d0) { s16x4 lo[4], hi[4];
#pragma unroll
        for (int ks = 0; ks < 4; ++ks) {
            asm volatile("ds_read_b64_tr_b16 %0,%1 offset:%c2" : "=&v"(lo[ks]) : "v"(vb), "i"(d0 * 4096 + ks * 1024) : "memory");
            asm volatile("ds_read_b64_tr_b16 %0,%1 offset:%c2" : "=&v"(hi[ks]) : "v"(vb), "i"(d0 * 4096 + ks * 1024 + 512) : "memory"); }
        asm volatile("s_waitcnt lgkmcnt(0)" ::: "memory"); SBAR();
#define PK(k) (bf16x8){lo[k][0], lo[k][1], lo[k][2], lo[k][3], hi[k][0], hi[k][1], hi[k][2], hi[k][3]}
        o[d0] = __builtin_amdgcn_mfma_f32_32x32x16_bf16(pa0, PK(0), o[d0], 0, 0, 0);
        o[d0] = __builtin_amdgcn_mfma_f32_32x32x16_bf16(pa1, PK(1), o[d0], 0, 0, 0);
        o[d0] = __builtin_amdgcn_mfma_f32_32x32x16_bf16(pa2, PK(2), o[d0], 0, 0, 0);
        o[d0] = __builtin_amdgcn_mfma_f32_32x32x16_bf16(pa3, PK(3), o[d0], 0, 0, 0);
#undef PK
    }
}
__device__ __forceinline__ void qkt(f32x16& p0, f32x16& p1, const bf16x8 (&kf)[8], const bf16x8 (&qr)[4]) {
    p0 = (f32x16){}; p1 = (f32x16){};
#pragma unroll
    for (int d0 = 0; d0 < 4; ++d0) { p0 = __builtin_amdgcn_mfma_f32_32x32x16_bf16(kf[2 * d0], qr[d0], p0, 0, 0, 0); p1 = __builtin_amdgcn_mfma_f32_32x32x16_bf16(kf[2 * d0 + 1], qr[d0], p1, 0, 0, 0); }
}
__device__ __forceinline__ void load_k(bf16x8 (&kf)[8], const bf16* k0, const bf16* k1) {
#pragma unroll
    for (int d0 = 0; d0 < 4; ++d0) { kf[2 * d0] = *(const GAS bf16x8*)(k0 + 16 * d0); kf[2 * d0 + 1] = *(const GAS bf16x8*)(k1 + 16 * d0); }
}
__device__ __forceinline__ void stage_v(const bf16* v0, const bf16* v1, const bf16* v2, const bf16* v3, LAS unsigned char* slot) {
    const bf16* vg[4] = {v0, v1, v2, v3};
#pragma unroll
    for (int dh = 0; dh < 2; ++dh)
#pragma unroll
        for (int kg = 0; kg < 4; ++kg)
            __builtin_amdgcn_global_load_lds((const unsigned*)(vg[kg] + dh * 32), (LAS unsigned*)(slot + (dh * 4 + kg) * 1024), 16, 0, 0);
}
__device__ __forceinline__ float swap_max(float m) { auto rr = __builtin_amdgcn_permlane32_swap(__float_as_uint(m), __float_as_uint(m), false, false); return fmaxf(__uint_as_float(rr[0]), __uint_as_float(rr[1])); }
__device__ __forceinline__ float swap_sum(float m) { auto rr = __builtin_amdgcn_permlane32_swap(__float_as_uint(m), __float_as_uint(m), false, false); return __uint_as_float(rr[0]) + __uint_as_float(rr[1]); }
__device__ __forceinline__ float rowmax32(const f32x16& p0, const f32x16& p1) {
    float a = fmaxf(p0[0], p1[0]);
#pragma unroll
    for (int r = 1; r < 16; ++r) a = fmaxf(a, fmaxf(p0[r], p1[r]));
    return swap_max(a);
}
__device__ __forceinline__ void scale_rows(f32x16 (&o)[2], LAS float* wsf, float f, int r32, int hi) {
    if (hi == 0) wsf[r32] = f;
#pragma unroll
    for (int r = 0; r < 16; ++r) { const float fr = wsf[crow(r, hi)]; o[0][r] *= fr; o[1][r] *= fr; }
}
#define PACK4(P, B) (v4u){pk2(P[B], P[B + 1]), pk2(P[B + 2], P[B + 3]), pk2(P[B + 4], P[B + 5]), pk2(P[B + 6], P[B + 7])}
__device__ __forceinline__ void softmax_step(f32x16& p0, f32x16& p1, float& m, float& lsum, f32x16 (&o)[2], LAS float* wsf, int r32, int hi) {
    const float rm = rowmax32(p0, p1), mnew = fmaxf(m, rm);
    if (__any(mnew > m)) { const float f = __builtin_amdgcn_exp2f(m - mnew); lsum *= f; scale_rows(o, wsf, f, r32, hi); m = mnew; }
    float s = 0.f;
#pragma unroll
    for (int r = 0; r < 16; ++r) { p0[r] = __builtin_amdgcn_exp2f(p0[r] - m); p1[r] = __builtin_amdgcn_exp2f(p1[r] - m); s += p0[r] + p1[r]; }
    lsum += s;
}
__device__ __forceinline__ void pv_tile(f32x16 (&o)[2], const f32x16& p0, const f32x16& p1, int vb) {
    const v4u w0 = PACK4(p0, 0), w1 = PACK4(p0, 8), w2 = PACK4(p1, 0), w3 = PACK4(p1, 8);
    asm volatile("s_waitcnt vmcnt(0)" ::: "memory");
    pv(o, vb, __builtin_bit_cast(bf16x8, w0), __builtin_bit_cast(bf16x8, w1), __builtin_bit_cast(bf16x8, w2), __builtin_bit_cast(bf16x8, w3));
}
struct WaveCtx { int lane, r32, hi, wid; LAS unsigned char* vslot; LAS float* wsf; int vb; };
__device__ __forceinline__ WaveCtx make_ctx(LAS unsigned char* lds) {
    int tid_o = threadIdx.x; asm volatile("" : "+v"(tid_o));
    WaveCtx c; c.lane = tid_o & 63; c.r32 = c.lane & 31; c.hi = c.lane >> 5; c.wid = __builtin_amdgcn_readfirstlane(tid_o >> 6);
    c.vslot = lds + c.wid * 8192; c.wsf = (LAS float*)(lds + EXTRA_OFF + 2048 + c.wid * 256);
    c.vb = (int)(unsigned)(uintptr_t)c.vslot + ((c.lane >> 4) & 1) * 32 + (c.lane & 3) * 8 + (4 * c.hi + ((c.lane & 15) >> 2)) * 64;
    return c;
}
__device__ __forceinline__ void store_o(const f32x16 (&o)[2], const WaveCtx& c, bf16* obuf, size_t row0, int col0, bool use_scale) {
#pragma unroll
    for (int r = 0; r < 16; ++r) { const int q = crow(r, c.hi); const float f = use_scale ? c.wsf[q] : 1.0f;
        bf16* op = obuf + (row0 + q) * DM + col0 + c.r32;
        op[0] = (bf16)(pk2(o[0][r] * f, 0.f) & 0xffffu); op[32] = (bf16)(pk2(o[1][r] * f, 0.f) & 0xffffu); }
}

__device__ __forceinline__ void attA_unit(int b, int h, int qb, const bf16* proj, const unsigned long long* maskw, bf16* obuf, LAS unsigned char* lds, float slope2) {
    const WaveCtx c = make_ctx(lds);
    const int tq0 = 256 * qb + 32 * c.wid, t = tq0 + c.r32;
    const size_t rowbase = (size_t)b * SEQ;
    bf16x8 qr[4];
    { const bf16* Qp = proj + (rowbase + t) * NPROJ + PC_QA + h * 64 + c.hi * 8;
#pragma unroll
      for (int d0 = 0; d0 < 4; ++d0) qr[d0] = *(const GAS bf16x8*)(Qp + 16 * d0); }
    const bf16* Kh = proj + (rowbase + c.r32) * NPROJ + PC_KA + h * 64 + c.hi * 8;
    const bf16* Vh = proj + (rowbase + (c.lane >> 2)) * NPROJ + PC_VA + h * 64 + (c.lane & 3) * 8;
    const unsigned long long* mwp = maskw + (size_t)b * 64 * SEQ + t;
    const int njt = (tq0 + 31) / 64 + 1;
    float m = -1e30f, lsum = 0.f; f32x16 o[2]; o[0] = (f32x16){}; o[1] = (f32x16){};
    for (int j = 0; j < njt; ++j) {
        bf16x8 kf[8]; const bf16* kt = Kh + (size_t)(64 * j) * NPROJ; load_k(kf, kt, kt + (size_t)32 * NPROJ);
        const bf16* vt = Vh + (size_t)(64 * j) * NPROJ; stage_v(vt, vt + (size_t)16 * NPROJ, vt + (size_t)32 * NPROJ, vt + (size_t)48 * NPROJ, c.vslot);
        const unsigned long long mw = mwp[(size_t)j * SEQ];
        f32x16 p0, p1; qkt(p0, p1, kf, qr);
        const float base = slope2 * (float)(64 * j + 4 * c.hi - t);
        const unsigned wl = (unsigned)mw >> (4 * c.hi), wh = (unsigned)(mw >> 32) >> (4 * c.hi);
#pragma unroll
        for (int r = 0; r < 16; ++r) { const int cr = (r & 3) + 8 * (r >> 2);
            const float x0 = p0[r] + (base + slope2 * (float)cr), x1 = p1[r] + (base + slope2 * (float)(cr + 32));
            p0[r] = ((wl >> cr) & 1u) ? x0 : -INFINITY; p1[r] = ((wh >> cr) & 1u) ? x1 : -INFINITY; }
        softmax_step(p0, p1, m, lsum, o, c.wsf, c.r32, c.hi);
        pv_tile(o, p0, p1, c.vb);
    }
    const float l = swap_sum(lsum);
    if (c.hi == 0) c.wsf[c.r32] = 1.0f / l;
    store_o(o, c, obuf, rowbase + tq0, h * 64, true);
}

__device__ __forceinline__ void attB_unit(int b, int h, int qb, const bf16* proj, bf16* obuf, LAS unsigned char* lds) {
    const WaveCtx c = make_ctx(lds);
    const int tq0 = 256 * qb + 32 * c.wid, t = tq0 + c.r32;
    const size_t rowbase = (size_t)b * SEQ;
    bf16x8 qr[4];
    { const bf16* Qp = proj + (rowbase + t) * NPROJ + PC_QB + h * 64 + c.hi * 8;
#pragma unroll
      for (int d0 = 0; d0 < 4; ++d0) qr[d0] = *(const GAS bf16x8*)(Qp + 16 * d0); }
    const bf16* Kh = proj + (rowbase + c.r32) * NPROJ + PC_KB + h * 64 + c.hi * 8;
    const bf16* Vh = proj + (rowbase + (c.lane >> 2)) * NPROJ + PC_VB + h * 64 + (c.lane & 3) * 8;
    const int jd = tq0 >> 6;
    float R = 0.f; f32x16 o[2]; o[0] = (f32x16){}; o[1] = (f32x16){};
    for (int j = jd; j >= 0; --j) {
        bf16x8 kf[8]; const bf16* kt = Kh + (size_t)(64 * j) * NPROJ; load_k(kf, kt, kt + (size_t)32 * NPROJ);
        const bf16* vt = Vh + (size_t)(64 * j) * NPROJ; stage_v(vt, vt + (size_t)16 * NPROJ, vt + (size_t)32 * NPROJ, vt + (size_t)48 * NPROJ, c.vslot);
        f32x16 z0, z1; qkt(z0, z1, kf, qr);
        f32x16 L0, L1;
#pragma unroll
        for (int r = 0; r < 16; ++r) {
            L0[r] = -(fmaxf(z0[r], 0.f) + __builtin_amdgcn_logf(1.0f + __builtin_amdgcn_exp2f(-fabsf(z0[r]))));
            L1[r] = -(fmaxf(z1[r], 0.f) + __builtin_amdgcn_logf(1.0f + __builtin_amdgcn_exp2f(-fabsf(z1[r])))); }
        const bool diag = (j == jd);
        if (diag) {
#pragma unroll
            for (int r = 0; r < 16; ++r) { const int s = 64 * j + crow(r, c.hi); if (!(s < t)) L0[r] = 0.f; if (!(s + 32 < t)) L1[r] = 0.f; }
        }
        float gs[8], T[8], pr[8];
#pragma unroll
        for (int k = 0; k < 4; ++k) { gs[k] = (L0[4 * k] + L0[4 * k + 1]) + (L0[4 * k + 2] + L0[4 * k + 3]); gs[k + 4] = (L1[4 * k] + L1[4 * k + 1]) + (L1[4 * k + 2] + L1[4 * k + 3]); }
#pragma unroll
        for (int k = 0; k < 8; ++k) { auto rr = __builtin_amdgcn_permlane32_swap(__float_as_uint(gs[k]), __float_as_uint(gs[k]), false, false);
            const float lo = __uint_as_float(rr[0]), hv = __uint_as_float(rr[1]); T[k] = lo + hv; pr[k] = c.hi ? lo : hv; }
        float ST = 0.f;
#pragma unroll
        for (int k = 7; k >= 0; --k) {
            const float E = R + ST + (c.hi == 0 ? pr[k] : 0.f);
            if (k >= 4) { const int b4 = 4 * (k - 4);
                const float c3 = E, c2 = c3 + L1[b4 + 3], c1 = c2 + L1[b4 + 2], c0 = c1 + L1[b4 + 1];
                z1[b4 + 3] = __builtin_amdgcn_exp2f(z1[b4 + 3] + L1[b4 + 3] + c3); z1[b4 + 2] = __builtin_amdgcn_exp2f(z1[b4 + 2] + L1[b4 + 2] + c2);
                z1[b4 + 1] = __builtin_amdgcn_exp2f(z1[b4 + 1] + L1[b4 + 1] + c1); z1[b4] = __builtin_amdgcn_exp2f(z1[b4] + L1[b4] + c0);
            } else { const int b4 = 4 * k;
                const float c3 = E, c2 = c3 + L0[b4 + 3], c1 = c2 + L0[b4 + 2], c0 = c1 + L0[b4 + 1];
                z0[b4 + 3] = __builtin_amdgcn_exp2f(z0[b4 + 3] + L0[b4 + 3] + c3); z0[b4 + 2] = __builtin_amdgcn_exp2f(z0[b4 + 2] + L0[b4 + 2] + c2);
                z0[b4 + 1] = __builtin_amdgcn_exp2f(z0[b4 + 1] + L0[b4 + 1] + c1); z0[b4] = __builtin_amdgcn_exp2f(z0[b4] + L0[b4] + c0);
            }
            ST += T[k];
        }
        R += ST;
        if (diag) {
#pragma unroll
            for (int r = 0; r < 16; ++r) { const int s = 64 * j + crow(r, c.hi); if (!(s < t)) z0[r] = 0.f; if (!(s + 32 < t)) z1[r] = 0.f; }
        }
        pv_tile(o, z0, z1, c.vb);
        if (__all(R < -150.0f)) break;
    }
    store_o(o, c, obuf, rowbase + tq0, 256 + h * 64, false);
}

__device__ __forceinline__ void attC_unit(int b, int h, int blk, const bf16* proj, bf16* obuf, LAS unsigned char* lds, float slope2) {
    const WaveCtx c = make_ctx(lds);
    LAS bf16* oacc = (LAS bf16*)(lds + 65536); LAS float* lse = (LAS float*)(lds + EXTRA_OFF);
    const int T0 = 512 * blk; const size_t rowbase = (size_t)b * SEQ;
    const bf16* Kb = proj + rowbase * NPROJ + PC_KC + h * 64 + c.hi * 8;
    const bf16* Vb = proj + rowbase * NPROJ + PC_VC + h * 64 + (c.lane & 3) * 8;
#pragma unroll 1
    for (int br = 0; br < 3; ++br) {
        const int sh = 2 * br; const float sl2 = slope2 * (float)(1 << sh);
#pragma unroll 1
        for (int jj = 0; jj < 2; ++jj) {
            const int jt = c.wid + 8 * jj;
            int cc, u0;
            if (br == 0) { cc = 0; u0 = T0 + 32 * jt; } else if (br == 1) { cc = jt & 3; u0 = (T0 >> 2) + 32 * (jt >> 2); } else { cc = jt; u0 = T0 >> 4; }
            const int qu = u0 + c.r32, t = cc + (qu << sh);
            bf16x8 qr[4];
            { const bf16* Qp = proj + (rowbase + t) * NPROJ + PC_QC + h * 64 + c.hi * 8;
#pragma unroll
              for (int d0 = 0; d0 < 4; ++d0) qr[d0] = *(const GAS bf16x8*)(Qp + 16 * d0); }
            float m = -1e30f, lsum = 0.f; f32x16 o[2]; o[0] = (f32x16){}; o[1] = (f32x16){};
#pragma unroll 1
            for (int kt = 0; kt < 3; ++kt) {
                const int ku0 = u0 - 160 + 64 * kt;
                if (ku0 + 63 < 0) continue;
                bf16x8 kf[8];
                { const int ka = ku0 + c.r32, kb2 = ka + 32; const int ta = cc + ((ka < 0 ? 0 : ka) << sh), tb = cc + ((kb2 < 0 ? 0 : kb2) << sh);
                  load_k(kf, Kb + (size_t)ta * NPROJ, Kb + (size_t)tb * NPROJ); }
                { const bf16* vg[4];
#pragma unroll
                  for (int kg = 0; kg < 4; ++kg) { const int kv = ku0 + 16 * kg + (c.lane >> 2); vg[kg] = Vb + (size_t)(cc + ((kv < 0 ? 0 : kv) << sh)) * NPROJ; }
                  stage_v(vg[0], vg[1], vg[2], vg[3], c.vslot); }
                f32x16 p0, p1; qkt(p0, p1, kf, qr);
#pragma unroll
                for (int r = 0; r < 16; ++r) { const int k0 = ku0 + crow(r, c.hi), k1 = k0 + 32, d0 = qu - k0, d1 = qu - k1;
                    p0[r] = (k0 >= 0 && d0 >= 0 && d0 <= 128) ? p0[r] - sl2 * (float)d0 : -INFINITY;
                    p1[r] = (k1 >= 0 && d1 >= 0 && d1 <= 128) ? p1[r] - sl2 * (float)d1 : -INFINITY; }
                softmax_step(p0, p1, m, lsum, o, c.wsf, c.r32, c.hi);
                pv_tile(o, p0, p1, c.vb);
            }
            const float l = swap_sum(lsum), lb = m + __builtin_amdgcn_logf(l);
            const int tl = t - T0;
            if (c.hi == 0) { c.wsf[c.r32] = 1.0f / l; c.wsf[32 + c.r32] = lb; }
            float lnew = lb;
            if (br > 0) { const float lo = lse[tl], mx = fmaxf(lo, lb); lnew = mx + __builtin_amdgcn_logf(__builtin_amdgcn_exp2f(lo - mx) + __builtin_amdgcn_exp2f(lb - mx)); }
#pragma unroll
            for (int r = 0; r < 16; ++r) { const int q = crow(r, c.hi); const int tlr = cc + ((u0 + q) << sh) - T0;
                const float inv = c.wsf[q]; float v0 = o[0][r] * inv, v1 = o[1][r] * inv;
                if (br > 0) { const float lbr = c.wsf[32 + q], lo = lse[tlr], mx = fmaxf(lo, lbr), eo = __builtin_amdgcn_exp2f(lo - mx), eb = __builtin_amdgcn_exp2f(lbr - mx), rd = 1.0f / (eo + eb);
                    const float wo = eo * rd, wb = eb * rd;
                    v0 = wo * bf2f(oacc[tlr * 64 + c.r32]) + wb * v0; v1 = wo * bf2f(oacc[tlr * 64 + 32 + c.r32]) + wb * v1; }
                if (br < 2) { oacc[tlr * 64 + c.r32] = (bf16)(pk2(v0, 0.f) & 0xffffu); oacc[tlr * 64 + 32 + c.r32] = (bf16)(pk2(v1, 0.f) & 0xffffu); }
                else { bf16* op = obuf + (rowbase + T0 + tlr) * DM + 512 + h * 64 + c.r32; op[0] = (bf16)(pk2(v0, 0.f) & 0xffffu); op[32] = (bf16)(pk2(v1, 0.f) & 0xffffu); }
            }
            LDS_WAIT();
            if (br < 2 && c.hi == 0) lse[tl] = lnew;
        }
        __syncthreads();
    }
}
#undef SBAR
}

__device__ __forceinline__ void idx_unit(Frame& F, int b, int qg, const bf16* proj, unsigned long long* maskw) {
    typedef float f32x16 __attribute__((ext_vector_type(16)));
    LAS unsigned* sc = (LAS unsigned*)F.lds;
    const int lane = F.lane, r32 = lane & 31, hi = lane >> 5, wid = F.wave;
    const int t0 = 8 * qg; const size_t rowbase = (size_t)b * SEQ;
    if (t0 + 7 >= 256) {
        const int ntile = (t0 + 8 + 31) / 32;
        bf16x8 qf[2][4]; float wv[2][16];
#pragma unroll
        for (int rt = 0; rt < 2; ++rt) { const bf16* qp = proj + (rowbase + t0 + 4 * rt + (r32 >> 3)) * NPROJ + PC_QI + (r32 & 7) * 64 + 8 * hi;
#pragma unroll
            for (int ks = 0; ks < 4; ++ks) qf[rt][ks] = *(const GAS bf16x8*)(qp + 16 * ks);
#pragma unroll
            for (int i = 0; i < 16; ++i) wv[rt][i] = bf2f(proj[(rowbase + t0 + 4 * rt + (i >> 2)) * NPROJ + PC_WI + (i & 3) + 4 * hi]); }
        for (int kt = wid; kt < ntile; kt += NWAVES) {
            bf16x8 kf[4]; const bf16* kp = proj + (rowbase + 32 * kt + r32) * NPROJ + PC_KI + 8 * hi;
#pragma unroll
            for (int ks = 0; ks < 4; ++ks) kf[ks] = *(const GAS bf16x8*)(kp + 16 * ks);
#pragma unroll
            for (int rt = 0; rt < 2; ++rt) { f32x16 acc = (f32x16){};
#pragma unroll
                for (int ks = 0; ks < 4; ++ks) acc = __builtin_amdgcn_mfma_f32_32x32x16_bf16(qf[rt][ks], kf[ks], acc, 0, 0, 0);
                float s[4];
#pragma unroll
                for (int tq = 0; tq < 4; ++tq) { float a = 0.f;
#pragma unroll
                    for (int j = 0; j < 4; ++j) a = fmaf(wv[rt][4 * tq + j], fmaxf(acc[4 * tq + j], 0.f), a);
                    s[tq] = a; }
#pragma unroll
                for (int pp = 0; pp < 2; ++pp) { auto rr = __builtin_amdgcn_permlane32_swap(__float_as_uint(s[2 * pp]), __float_as_uint(s[2 * pp + 1]), false, false);
                    const float v = (__uint_as_float(rr[0]) + __uint_as_float(rr[1])) + 0.0f;
                    const int q = 4 * rt + 2 * pp + hi, key = 32 * kt + r32;
                    unsigned u = __float_as_uint(v); u ^= ((unsigned)((int)u >> 31) | 0x80000000u);
                    sc[q * SEQ + key] = (key <= t0 + q) ? u : 0u; }
            }
        }
    }
    __syncthreads();
    {
        const int t = t0 + wid, n = t + 1;
        unsigned long long myword = 0ull;
        if (n <= 256) {
#pragma unroll
            for (int r = 0; r < 4; ++r) { const unsigned long long mm = __ballot(64 * r + lane <= t); if (lane == r) myword = mm; }
        } else {
            const int nreg = (n + 63) >> 6;
            unsigned x[64];
#pragma unroll
            for (int g = 0; g < 8; ++g) {
                if (8 * g < nreg) {
#pragma unroll
                    for (int j = 0; j < 8; ++j) { const int r = 8 * g + j; const unsigned u = sc[wid * SEQ + 64 * r + lane]; x[r] = (64 * r + lane <= t) ? u : 0u; }
                } else {
#pragma unroll
                    for (int j = 0; j < 8; ++j) x[8 * g + j] = 0u;
                }
            }
            unsigned v = 0u;
#pragma unroll 1
            for (int bit = 31; bit >= 0; --bit) {
                const unsigned cand = v | (1u << bit); int cnt = 0;
#pragma unroll
                for (int g = 0; g < 8; ++g) if (8 * g < nreg) {
#pragma unroll
                    for (int j = 0; j < 8; ++j) cnt += __builtin_popcountll(__ballot(x[8 * g + j] >= cand));
                }
                if (cnt >= 256) v = cand;
            }
            int cgt = 0;
#pragma unroll
            for (int g = 0; g < 8; ++g) if (8 * g < nreg) {
#pragma unroll
                for (int j = 0; j < 8; ++j) cgt += __builtin_popcountll(__ballot(x[8 * g + j] > v));
            }
            const int ntake = 256 - cgt; int taken = 0;
#pragma unroll
            for (int g = 0; g < 8; ++g) if (8 * g < nreg) {
#pragma unroll
                for (int j = 0; j < 8; ++j) { const int r = 8 * g + j; const bool eq = (x[r] == v), gt = (x[r] > v);
                    const unsigned long long eqm = __ballot(eq);
                    const int rank = taken + (int)__builtin_amdgcn_mbcnt_hi((unsigned)(eqm >> 32), __builtin_amdgcn_mbcnt_lo((unsigned)eqm, 0u));
                    const unsigned long long mm = __ballot(gt || (eq && rank < ntake));
                    if (lane == r) myword = mm;
                    taken += __builtin_popcountll(eqm); }
            }
        }
        maskw[((size_t)b * 64 + lane) * SEQ + t] = myword;
    }
    __syncthreads();
}

#ifndef MK_SPLIT
#define MK_SPLIT 0
#endif
constexpr int N_PHASES = 25;
__global__ void __launch_bounds__(NWAVES * 64, 2) fwd_kernel(Ptrs P) {
    extern __shared__ __attribute__((aligned(16))) unsigned char lds_raw[];
    Frame F;
    F.lds = (LAS unsigned char*)lds_raw;
    volatile LAS unsigned* MISC = (volatile LAS unsigned*)(F.lds + MISC_OFF);
    F.tid = threadIdx.x; F.lane = F.tid & 63; F.wave = __builtin_amdgcn_readfirstlane(F.tid >> 6);
    F.G = gridDim.x; { const int bx = blockIdx.x; F.vcu = (F.G % 8 == 0) ? (bx % 8) * (F.G / 8) + bx / 8 : bx; }
    for (int u = F.tid; u < (LDS_BYTES - LDSCTL_OFF) / 4; u += NWAVES * 64) ((LAS unsigned*)(F.lds + LDSCTL_OFF))[u] = 0u;
    __syncthreads();
    unsigned* ctl = (unsigned*)(P.ws + WS_CTL);
    XcdBarrier bar; bar.bar = ctl + CW_BAR; bar.x = 0; bar.st = nullptr;
    if (!MK_SPLIT) bar = xcd_barrier_post(ctl + CW_BAR, MISC + 8);
    const int lo = P.ph_lo, hi = P.ph_hi;
    int ph = 0;
#define PH_BEGIN if (lo <= ph && ph < hi) { asm volatile("" : "+v"(F.tid)); F.lane = F.tid & 63;
#define PH_END   if (!MK_SPLIT && ph + 1 < hi) xcd_barrier(bar); } ++ph;

    bf16* const H = (bf16*)(P.ws + WS_H); bf16* const PROJ = (bf16*)(P.ws + WS_PROJ); bf16* const ACT = (bf16*)(P.ws + WS_PROJ); bf16* const OB = (bf16*)(P.ws + WS_O);
    unsigned long long* const MASKW = (unsigned long long*)(P.ws + WS_MASK);
    const float* const MOD = (const float*)(P.ws + WS_MOD);

    PH_BEGIN p0_prologue(F, P); PH_END

#pragma unroll 1
    for (int l = 0; l < 2; ++l) {
        unsigned char* const wl = P.ws + WS_W + (size_t)l * LAYER_W_BYTES;
        const float* const modl = MOD + (size_t)l * NB * NMODC;
        const float* const xin = (l == 0) ? P.x : P.out;
        PH_BEGIN norm_mod_phase(F, xin, P.norm_ffn1 + l * DM, modl, 0, 1, H); PH_END
        PH_BEGIN { pg8::Gemm g{H, (const bf16*)(wl + OFF_WGU1), MTOK, NGU, DM}; pg8::StaticOrder S; S.init(MTOK, NGU, F.G, (int)blockIdx.x);
                   pg8::EpiSwiGLU E{ACT, DFF}; pg8::gemm_phase<pg8::EpiSwiGLU, pg8::StaticOrder, true, true>(F.lds, g, S, E); } PH_END
        PH_BEGIN { pg8::Gemm g{ACT, (const bf16*)(wl + OFF_WD1), MTOK, DM, DFF}; pg8::StaticOrder S; S.init(MTOK, DM, F.G, (int)blockIdx.x);
                   pg8::EpiResid E{xin, P.out, modl, 2, 0.5f}; pg8::gemm_phase<pg8::EpiResid, pg8::StaticOrder, true, true>(F.lds, g, S, E); } PH_END
        PH_BEGIN norm_mod_phase(F, P.out, P.norm_mix + l * DM, modl, 3, 4, H); PH_END
        PH_BEGIN { pg8::Gemm g{H, (const bf16*)(wl + OFF_WIN), MTOK, NPROJ, DM}; pg8::StaticOrder S; S.init(MTOK, NPROJ, F.G, (int)blockIdx.x);
                   pg8::EpiProj E{PROJ, NPROJ, P.qn_a + l * 64, P.kn_a + l * 64, P.qn_c + l * 64, P.kn_c + l * 64, QSCALE};
                   pg8::gemm_phase<pg8::EpiProj, pg8::StaticOrder, true, true>(F.lds, g, S, E); } PH_END
        PH_BEGIN { for (int u = blockIdx.x; u < NB * 512; u += F.G) { const int b = u >> 9, r = u & 511, qg = r < 256 ? r : 767 - r; idx_unit(F, b, qg, PROJ, MASKW); } } PH_END
        PH_BEGIN {
            for (int p = F.vcu; p < 256; p += F.G) { const int bh = p >> 3, b = bh >> 2, h = bh & 3, s = p & 7; const float slope2 = exp2f(-(float)(2 * h + 2)) * LOG2E;
                att::attA_unit(b, h, s, PROJ, MASKW, OB, F.lds, slope2); att::attA_unit(b, h, 15 - s, PROJ, MASKW, OB, F.lds, slope2); }
            for (int u = F.vcu; u < 512; u += F.G) { const int bh = u >> 4; att::attB_unit(bh >> 2, bh & 3, u & 15, PROJ, OB, F.lds); }
            __syncthreads();
            for (int u = F.vcu; u < 512; u += F.G) { const int bh = u >> 3, h = bh & 7; const int idx = 3 * (h >> 1) + (h & 1);
                att::attC_unit(bh >> 3, h, u & 7, PROJ, OB, F.lds, exp2f(-(2.0f / 3.0f) * (float)(idx + 1)) * LOG2E); }
        } PH_END
        PH_BEGIN group_norm_phase(F, OB, H); PH_END
        PH_BEGIN { pg8::Gemm g{H, (const bf16*)(wl + OFF_WOUT), MTOK, DM, DM}; pg8::StaticOrder S; S.init(MTOK, DM, F.G, (int)blockIdx.x);
                   pg8::EpiResid E{P.out, P.out, modl, 5, 1.0f}; pg8::gemm_phase<pg8::EpiResid, pg8::StaticOrder, true, true>(F.lds, g, S, E); } PH_END
        PH_BEGIN norm_mod_phase(F, P.out, P.norm_ffn2 + l * DM, modl, 6, 7, H); PH_END
        PH_BEGIN { pg8::Gemm g{H, (const bf16*)(wl + OFF_WGU2), MTOK, NGU, DM}; pg8::StaticOrder S; S.init(MTOK, NGU, F.G, (int)blockIdx.x);
                   pg8::EpiSwiGLU E{ACT, DFF}; pg8::gemm_phase<pg8::EpiSwiGLU, pg8::StaticOrder, true, true>(F.lds, g, S, E); } PH_END
        PH_BEGIN { pg8::Gemm g{ACT, (const bf16*)(wl + OFF_WD2), MTOK, DM, DFF}; pg8::StaticOrder S; S.init(MTOK, DM, F.G, (int)blockIdx.x);
                   pg8::EpiResid E{P.out, P.out, modl, 8, 0.5f}; pg8::gemm_phase<pg8::EpiResid, pg8::StaticOrder, true, true>(F.lds, g, S, E); } PH_END
    }
#undef PH_BEGIN
#undef PH_END
}

extern "C" void kernel_launch(void* const* d_in, const int* in_sizes, int n_in, void* d_out, int out_size, void* d_ws, size_t ws_size, hipStream_t stream) {
    static int grid = 0;
    if (grid == 0) {
        if (n_in != 20 || in_sizes[0] != MTOK * DM || out_size != MTOK * DM || ws_size < WS_END) { fprintf(stderr, "kernel_launch: unexpected shapes (n_in %d, in0 %d, out %d, ws %zu); nothing launched\n", n_in, n_in > 0 ? in_sizes[0] : -1, out_size, ws_size); grid = -1; return; }
        int dev = 0, cus = 0, per_cu = 0;
        if (hipGetDevice(&dev) != hipSuccess || hipDeviceGetAttribute(&cus, hipDeviceAttributeMultiprocessorCount, dev) != hipSuccess) { grid = -1; return; }
        if (hipFuncSetAttribute((const void*)fwd_kernel, hipFuncAttributeMaxDynamicSharedMemorySize, LDS_BYTES) != hipSuccess) { fprintf(stderr, "kernel_launch: hipFuncSetAttribute failed\n"); grid = -1; return; }
        if (hipOccupancyMaxActiveBlocksPerMultiprocessor(&per_cu, (const void*)fwd_kernel, NWAVES * 64, LDS_BYTES) != hipSuccess || per_cu < 1)
            fprintf(stderr, "kernel_launch: note: occupancy query reports %d workgroups per CU\n", per_cu);
        (void)hipGetLastError();
        grid = cus;
    }
    if (grid < 0) return;
    if (hipMemsetAsync((char*)d_ws + WS_CTL, 0, CTL_ZERO_BYTES, stream) != hipSuccess) return;
    Ptrs a{};
    const float** pp = (const float**)&a;
    for (int i = 0; i < 20; ++i) pp[i] = (const float*)d_in[i];
    a.out = (float*)d_out; a.ws = (unsigned char*)d_ws;
#if MK_SPLIT
    for (int k = 0; k < N_PHASES; ++k) { a.ph_lo = k; a.ph_hi = k + 1; hipLaunchKernelGGL(fwd_kernel, dim3(grid), dim3(NWAVES * 64), LDS_BYTES, stream, a); }
#else
    a.ph_lo = 0; a.ph_hi = N_PHASES;
    hipLaunchKernelGGL(fwd_kernel, dim3(grid), dim3(NWAVES * 64), LDS_BYTES, stream, a);
#endif
    const hipError_t le = hipPeekAtLastError();
    if (le != hipSuccess) fprintf(stderr, "kernel_launch: launch failed: %s\n", hipGetErrorName(le));
}
```

```cpp
#include <hip/hip_runtime.h>
#include <cstdio>
#include <cstdint>
namespace pg8 {
#define PG8_LAS __attribute__((address_space(3)))
typedef unsigned short bf16_t;
typedef short bf16x8 __attribute__((ext_vector_type(8)));
typedef float f32x4 __attribute__((ext_vector_type(4)));
typedef unsigned u32x4 __attribute__((ext_vector_type(4)));
constexpr int BM = 256, BK = 64, HALF = 128, HTB = HALF * BK * 2  , STAGE_BYTES = 8 * HTB, NXCD = 8, WGM = 8;

__host__ __device__ __forceinline__ int lds_byte(int r, int c) { const int st = (r >> 4) * 2 + (c >> 5), rr = r & 15, cc = c & 31, ob = rr * 64 + cc * 2; return st * 1024 + (ob ^ (((ob >> 9) & 1) << 5)); }
__host__ __device__ __forceinline__ void stage_rc(int b, int& R, int& C) { const int st = b / 1024, sb = b % 1024, swz = sb ^ (((sb >> 9) & 1) << 5); R = (st >> 1) * 16 + swz / 64; C = (st & 1) * 32 + (swz % 64) / 2; }
__host__ __device__ __forceinline__ int perm32(int rho) { const int n = rho >> 4, i = rho & 15; return 8 * (i >> 2) + 4 * n + (i & 3); }

struct Unit { int pm, pn; };
struct Gemm { const bf16_t* A; const bf16_t* Bt; int M, N, K; };

struct StaticOrder {
    int nM, nN, nwg, G, c;
    __host__ __device__ void init(int M, int N, int G_, int c_) { nM = M / BM; nN = N / BM; nwg = nM * nN; G = G_; c = c_; }
    __host__ __device__ bool next(int i, Unit& u) const {
        const long L = (long)i * G + c; if (L >= nwg) return false;
        int wgid = (int)L; { const int q = nwg / NXCD, r = nwg % NXCD, xcd = wgid % NXCD, off = wgid / NXCD; wgid = (xcd < r ? xcd * (q + 1) : r * (q + 1) + (xcd - r) * q) + off; }
        const int nig = WGM * nN, gid = wgid / nig, fm = gid * WGM, gsz = (nM - fm) < WGM ? (nM - fm) : WGM;
        u.pm = fm + ((wgid % nig) % gsz); u.pn = (wgid % nig) / gsz; return true;
    }
    __device__ __forceinline__ void a_ready(const Unit&) const {}
    __device__ __forceinline__ void done(const Unit&) const {}
};

typedef float f32x2 __attribute__((ext_vector_type(2)));
typedef __bf16 bf16x2_t __attribute__((ext_vector_type(2)));
__device__ __forceinline__ unsigned cvt_pk_bf16(float lo, float hi) { f32x2 v = {lo, hi}; bf16x2_t b = __builtin_convertvector(v, bf16x2_t); return __builtin_bit_cast(unsigned, b); }

__device__ __forceinline__ float xsum16(float v) { auto t = __builtin_amdgcn_permlane16_swap(__float_as_uint(v), __float_as_uint(v), false, false); return __uint_as_float(t[0]) + __uint_as_float(t[1]); }
__device__ __forceinline__ float xsum32(float v) { auto t = __builtin_amdgcn_permlane32_swap(__float_as_uint(v), __float_as_uint(v), false, false); return __uint_as_float(t[0]) + __uint_as_float(t[1]); }
#define PG8_DPP_ADD(v, ctrl) ((v) + __uint_as_float((unsigned)__builtin_amdgcn_update_dpp(0, (int)__float_as_uint(v), ctrl, 0xF, 0xF, true)))
__device__ __forceinline__ float wave_sum_f(float v) {
    v = PG8_DPP_ADD(v, 0xB1); v = PG8_DPP_ADD(v, 0x4E); v = PG8_DPP_ADD(v, 0x141); v = PG8_DPP_ADD(v, 0x140);
    return xsum32(xsum16(v));
}
__device__ __forceinline__ unsigned pk4_fp8(float a, float b, float c, float d) {
    a = __builtin_amdgcn_fmed3f(a, -448.f, 448.f); b = __builtin_amdgcn_fmed3f(b, -448.f, 448.f); c = __builtin_amdgcn_fmed3f(c, -448.f, 448.f); d = __builtin_amdgcn_fmed3f(d, -448.f, 448.f);
    int w = __builtin_amdgcn_cvt_pk_fp8_f32(a, b, 0, false); w = __builtin_amdgcn_cvt_pk_fp8_f32(c, d, w, true); return (unsigned)w; }
template <bool F8OUT> struct EpiSwiGLU {
    static constexpr bool PERM = true, AFTER_DRAIN = false;
    bf16_t* O; int ldc;
    __device__ __forceinline__ void operator()(const f32x4 (&acc)[2][2][4][2], const Unit& u, int wr, int wc, int fr, int fq) const {
        const int row0 = u.pm * BM + wr * 64 + fr, col0 = u.pn * HALF + wc * 32 + 8 * fq;
#pragma unroll
        for (int ai = 0; ai < 2; ++ai)
#pragma unroll
            for (int m = 0; m < 4; ++m) {
                float v[8];
#pragma unroll
                for (int n = 0; n < 2; ++n)
#pragma unroll
                    for (int j = 0; j < 4; ++j) { const float g = acc[ai][0][m][n][j], up = acc[ai][1][m][n][j];
                        const float e = __builtin_amdgcn_exp2f(g * -1.4426950408889634f);
                        v[n * 4 + j] = g * __builtin_amdgcn_rcpf(1.0f + e) * up; }
                if constexpr (F8OUT) { typedef unsigned u32x2_ __attribute__((ext_vector_type(2))); unsigned char* rowp = (unsigned char*)O + (size_t)(row0 + ai * HALF + m * 16) * ldc + col0;
                    u32x2_ w; w.x = pk4_fp8(v[0], v[1], v[2], v[3]); w.y = pk4_fp8(v[4], v[5], v[6], v[7]); *(u32x2_*)rowp = w; }
                else { bf16_t* rowp = O + (size_t)(row0 + ai * HALF + m * 16) * ldc + col0;
                    u32x4 w; w.x = cvt_pk_bf16(v[0], v[1]); w.y = cvt_pk_bf16(v[2], v[3]); w.z = cvt_pk_bf16(v[4], v[5]); w.w = cvt_pk_bf16(v[6], v[7]);
                    *(u32x4*)rowp = w; }
            }
    }
};

struct EpiResid {
    static constexpr bool PERM = false, AFTER_DRAIN = false;
    const float* base; float* out; const float* modl; int chunk; float coef;
    __device__ __forceinline__ void operator()(const f32x4 (&acc)[2][2][4][2], const Unit& u, int wr, int wc, int fr, int fq) const {
        const int row0 = u.pm * BM + wr * 64 + fr, col0 = u.pn * BM + wc * 32 + 4 * fq;
        const float* gate = modl + (size_t)(u.pm >> 4) * 9216 + chunk * 1024;
        f32x4 gv[2][2];
#pragma unroll
        for (int bj = 0; bj < 2; ++bj)
#pragma unroll
            for (int n = 0; n < 2; ++n) gv[bj][n] = *(const f32x4*)(gate + col0 + bj * HALF + n * 16) * coef;
#pragma unroll
        for (int ai = 0; ai < 2; ++ai)
#pragma unroll
            for (int m = 0; m < 4; ++m) { const size_t off = (size_t)(row0 + ai * HALF + m * 16) * 1024 + col0;
#pragma unroll
                for (int bj = 0; bj < 2; ++bj)
#pragma unroll
                    for (int n = 0; n < 2; ++n) { const f32x4 bs = *(const f32x4*)(base + off + bj * HALF + n * 16);
                        *(f32x4*)(out + off + bj * HALF + n * 16) = bs + gv[bj][n] * acc[ai][bj][m][n]; }
                if (m & 1) asm volatile("" ::: "memory"); }
    }
};

struct EpiProj {
    static constexpr bool PERM = true, AFTER_DRAIN = false;
    bf16_t* P; int ldc; const float *qn_a, *kn_a, *qn_c, *kn_c; float qscale;
    __device__ __forceinline__ void operator()(const f32x4 (&acc)[2][2][4][2], const Unit& u, int wr, int wc, int fr, int fq) const {
        const int pn = u.pn;
        const float* gain = pn == 0 ? qn_a : pn == 1 ? kn_a : (pn == 6 || pn == 7) ? qn_c : (pn == 8 || pn == 9) ? kn_c : nullptr;
        const float sc = (pn == 0 || pn == 3 || pn == 6 || pn == 7) ? qscale : 1.0f;
        const int row0 = u.pm * BM + wr * 64 + fr, col0 = pn * BM + wc * 64 + 8 * fq;
        f32x4 gv[2][2];
#pragma unroll
        for (int bj = 0; bj < 2; ++bj)
#pragma unroll
            for (int n = 0; n < 2; ++n) gv[bj][n] = gain ? *(const f32x4*)(gain + 32 * bj + 8 * fq + 4 * n) * sc : (f32x4){sc, sc, sc, sc};
#pragma unroll
        for (int ai = 0; ai < 2; ++ai)
#pragma unroll
            for (int m = 0; m < 4; ++m) {
                float rs = 1.0f;
                if (gain) { float ss = 0.f;
#pragma unroll
                    for (int bj = 0; bj < 2; ++bj)
#pragma unroll
                        for (int n = 0; n < 2; ++n) { const f32x4 x = acc[ai][bj][m][n]; ss += (x[0] * x[0] + x[1] * x[1]) + (x[2] * x[2] + x[3] * x[3]); }
                    ss = xsum32(xsum16(ss));
                    rs = __builtin_amdgcn_rsqf(ss * (1.0f / 64.0f) + 1e-6f); }
                bf16_t* rowp = P + (size_t)(row0 + ai * HALF + m * 16) * ldc + col0;
#pragma unroll
                for (int bj = 0; bj < 2; ++bj) { const f32x4 v0 = acc[ai][bj][m][0] * gv[bj][0] * rs, v1 = acc[ai][bj][m][1] * gv[bj][1] * rs;
                    u32x4 w; w.x = cvt_pk_bf16(v0[0], v0[1]); w.y = cvt_pk_bf16(v0[2], v0[3]); w.z = cvt_pk_bf16(v1[0], v1[1]); w.w = cvt_pk_bf16(v1[2], v1[3]);
                    *(u32x4*)(rowp + 32 * bj) = w; }
            }
    }
};

template <class Epi, class Sched, bool ALIGN_EPI = false, bool SP2 = false, bool FP8 = false>
__device__ __forceinline__ void gemm_phase(PG8_LAS unsigned char* lds, const Gemm g, const Sched& S, const Epi& E, int wave_id) {
    int tid_o = wave_id * 64 + (int)__builtin_amdgcn_mbcnt_hi(~0u, __builtin_amdgcn_mbcnt_lo(~0u, 0u)); asm volatile("" : "+v"(tid_o));
    const int tid = tid_o, wid = __builtin_amdgcn_readfirstlane(tid >> 6), lane = tid & 63, wr = wid >> 2, wc = wid & 3, fr = lane & 15, fq = lane >> 4;
    const int K = g.K, nt = K / BK;
    unsigned voffA[2], voffB[2];
#pragma unroll
    for (int i = 0; i < 2; ++i) { int R, C; stage_rc(tid * 16 + i * 8192, R, C); const int Rb = Epi::PERM ? ((R & ~31) + perm32(R & 31)) : R;
        voffA[i] = (unsigned)(R * K + C) * 2u; voffB[i] = (unsigned)(Rb * K + C) * 2u; }
    const size_t kstep = (size_t)(BK * 2);
    const size_t hstep = (size_t)HALF * K * 2;
    const size_t tstep = 2 * hstep;
    const unsigned ldsw = (unsigned)wid * 1024u;
    const int aoff = lds_byte(wr * 64 + fr, fq * 8), boff = lds_byte(wc * 32 + fr, fq * 8);
#define PG8_SA(b, h) (((b) * 2 + (h)) * HTB)
#define PG8_SB(b, h) ((4 + (b) * 2 + (h)) * HTB)
#define PG8_STAGE(bufoff, gbase, voff) do { _Pragma("unroll") for (int _i = 0; _i < 2; ++_i) \
        __builtin_amdgcn_global_load_lds((const unsigned*)((const char*)(gbase) + (voff)[_i]), (PG8_LAS unsigned*)(lds + (bufoff) + ldsw + _i * 8192), 16, 0, 0); } while (0)
#define PG8_LDA(dst, b, h) do { _Pragma("unroll") for (int m = 0; m < 4; ++m) { \
        if constexpr (FP8) { dst##8[m].lo = *(const PG8_LAS i32x4_*)(lds + PG8_SA(b, h) + aoff + m * 2048); dst##8[m].hi = *(const PG8_LAS i32x4_*)(lds + PG8_SA(b, h) + aoff + m * 2048 + 1024); } \
        else { _Pragma("unroll") for (int k = 0; k < 2; ++k) dst[m][k] = *(const PG8_LAS bf16x8*)(lds + PG8_SA(b, h) + aoff + m * 2048 + k * 1024); } } } while (0)
#define PG8_LDB(dst, b, h) do { _Pragma("unroll") for (int n = 0; n < 2; ++n) { \
        if constexpr (FP8) { dst##8[n].lo = *(const PG8_LAS i32x4_*)(lds + PG8_SB(b, h) + boff + n * 2048); dst##8[n].hi = *(const PG8_LAS i32x4_*)(lds + PG8_SB(b, h) + boff + n * 2048 + 1024); } \
        else { _Pragma("unroll") for (int k = 0; k < 2; ++k) dst[n][k] = *(const PG8_LAS bf16x8*)(lds + PG8_SB(b, h) + boff + n * 2048 + k * 1024); } } } while (0)
#define PG8_MMA(ai, bj, At, Bt) do { __builtin_amdgcn_s_setprio(1); _Pragma("unroll") for (int m = 0; m < 4; ++m) _Pragma("unroll") for (int n = 0; n < 2; ++n) { \
          \
        if constexpr (FP8) asm volatile("v_mfma_scale_f32_16x16x128_f8f6f4 %0, %1, %2, %0, %3, %4 op_sel_hi:[0,0,0]" : "+v"(acc[ai][bj][m][n]) : "v"(Bt##8[n]), "v"(At##8[m]), "v"(scale_w_), "v"(scale_a_));   \
        else { _Pragma("unroll") for (int k = 0; k < 2; ++k) acc[ai][bj][m][n] = __builtin_amdgcn_mfma_f32_16x16x32_bf16(Bt[n][k], At[m][k], acc[ai][bj][m][n], 0, 0, 0); } } \
        __builtin_amdgcn_s_setprio(0); } while (0)
#define PG8_WAIT_V(n) asm volatile("s_waitcnt vmcnt(" #n ")" ::: "memory")
#define PG8_WAIT_L(n) asm volatile("s_waitcnt lgkmcnt(" #n ")" ::: "memory")
#define PG8_BAR __builtin_amdgcn_s_barrier()
#define PG8_SCHED __builtin_amdgcn_sched_barrier(0)
    Unit cur, nxt; int ui = 0;
    if (!S.next(0, cur)) return;
    f32x4 acc[2][2][4][2];
#pragma unroll
    for (int a = 0; a < 2; ++a)
#pragma unroll
        for (int b = 0; b < 2; ++b)
#pragma unroll
            for (int m = 0; m < 4; ++m)
#pragma unroll
                for (int n = 0; n < 2; ++n) acc[a][b][m][n] = (f32x4){0.f, 0.f, 0.f, 0.f};
    typedef int i32x8_ __attribute__((ext_vector_type(8))); typedef int i32x4_ __attribute__((ext_vector_type(4)));
    const int scale_w_ = 122, scale_a_ = 127;
    bf16x8 At[4][2], B0[2][2], B1[2][2]; i32x8_ At8[4], B08[2], B18[2];
    const char* cA = (const char*)g.A + (size_t)cur.pm * tstep; const char* cB = (const char*)g.Bt + (size_t)cur.pn * tstep;
    S.a_ready(cur);
    if constexpr (SP2) {
        PG8_STAGE(PG8_SB(0, 0), cB, voffB); PG8_STAGE(PG8_SB(0, 1), cB + hstep, voffB); PG8_STAGE(PG8_SA(0, 0), cA, voffA); PG8_STAGE(PG8_SA(0, 1), cA + hstep, voffA);
        if (wr == 1) PG8_BAR;
        PG8_WAIT_V(2); PG8_BAR;
        PG8_STAGE(PG8_SB(1, 0), cB + kstep, voffB); PG8_STAGE(PG8_SA(1, 0), cA + kstep, voffA); PG8_STAGE(PG8_SB(1, 1), cB + hstep + kstep, voffB);
        PG8_WAIT_V(6); PG8_BAR;
    } else {
        PG8_STAGE(PG8_SB(0, 0), cB, voffB); PG8_STAGE(PG8_SA(0, 0), cA, voffA); PG8_STAGE(PG8_SB(0, 1), cB + hstep, voffB); PG8_STAGE(PG8_SA(0, 1), cA + hstep, voffA);
        if (wr == 1) PG8_BAR;
        PG8_WAIT_V(4); PG8_BAR;
        PG8_STAGE(PG8_SB(1, 0), cB + kstep, voffB); PG8_STAGE(PG8_SA(1, 0), cA + kstep, voffA); PG8_STAGE(PG8_SB(1, 1), cB + hstep + kstep, voffB);
        PG8_WAIT_V(6); PG8_BAR;
    }
    for (;;) {
        const bool has_next = S.next(ui + 1, nxt);
        const char* nA = has_next ? (const char*)g.A + (size_t)nxt.pm * tstep : cA; const char* nB = has_next ? (const char*)g.Bt + (size_t)nxt.pn * tstep : cB;
        _Pragma("unroll 1") for (int t = 0; t < nt; t += 2) {
            const bool last = (t == nt - 2);
            const char* a1 = cA + (size_t)(t + 1) * kstep;
            const char* a2 = last ? nA : cA + (size_t)(t + 2) * kstep; const char* b2 = last ? nB : cB + (size_t)(t + 2) * kstep;
            const char* a3 = a2 + kstep; const char* b3 = b2 + kstep;
            if (last && has_next) S.a_ready(nxt);
            if constexpr (SP2) {
            PG8_LDB(B0, 0, 0); PG8_LDB(B1, 0, 1); PG8_SCHED; PG8_LDA(At, 0, 0); PG8_STAGE(PG8_SA(1, 1), a1 + hstep, voffA);
            PG8_WAIT_V(8); PG8_WAIT_L(0); PG8_BAR; PG8_MMA(0, 0, At, B0); PG8_MMA(0, 1, At, B1); PG8_BAR; PG8_SCHED;
            PG8_LDA(At, 0, 1); PG8_STAGE(PG8_SB(0, 0), b2, voffB); PG8_STAGE(PG8_SB(0, 1), b2 + hstep, voffB); PG8_STAGE(PG8_SA(0, 0), a2, voffA);
            PG8_WAIT_V(8); PG8_WAIT_L(0); PG8_BAR; PG8_MMA(1, 0, At, B0); PG8_MMA(1, 1, At, B1); PG8_BAR; PG8_SCHED;
            PG8_LDB(B0, 1, 0); PG8_LDB(B1, 1, 1); PG8_SCHED; PG8_LDA(At, 1, 0); PG8_STAGE(PG8_SA(0, 1), a2 + hstep, voffA);
            PG8_WAIT_V(8); PG8_WAIT_L(0); PG8_BAR; PG8_MMA(0, 0, At, B0); PG8_MMA(0, 1, At, B1); PG8_BAR; PG8_SCHED;
            PG8_LDA(At, 1, 1); PG8_STAGE(PG8_SB(1, 0), b3, voffB); PG8_STAGE(PG8_SB(1, 1), b3 + hstep, voffB); PG8_STAGE(PG8_SA(1, 0), a3, voffA);
            PG8_WAIT_V(8); PG8_WAIT_L(0); PG8_BAR; PG8_MMA(1, 0, At, B0); PG8_MMA(1, 1, At, B1); PG8_BAR; PG8_SCHED;
            } else {
            PG8_LDB(B0, 0, 0); PG8_SCHED; PG8_LDA(At, 0, 0); PG8_STAGE(PG8_SA(1, 1), a1 + hstep, voffA);
            PG8_WAIT_L(8); PG8_BAR; PG8_WAIT_L(0); PG8_MMA(0, 0, At, B0); PG8_BAR; PG8_SCHED;
            PG8_LDB(B1, 0, 1); PG8_STAGE(PG8_SB(0, 0), b2, voffB);
            PG8_BAR; PG8_WAIT_L(0); PG8_MMA(0, 1, At, B1); PG8_BAR;
            PG8_LDA(At, 0, 1); PG8_STAGE(PG8_SA(0, 0), a2, voffA);
            PG8_BAR; PG8_WAIT_L(0); PG8_MMA(1, 0, At, B0); PG8_BAR; PG8_SCHED;
            PG8_STAGE(PG8_SB(0, 1), b2 + hstep, voffB);
            PG8_WAIT_V(6); PG8_BAR; PG8_MMA(1, 1, At, B1); PG8_BAR;
            PG8_LDB(B0, 1, 0); PG8_SCHED; PG8_LDA(At, 1, 0); PG8_STAGE(PG8_SA(0, 1), a2 + hstep, voffA);
            PG8_WAIT_L(8); PG8_BAR; PG8_WAIT_L(0); PG8_MMA(0, 0, At, B0); PG8_BAR; PG8_SCHED;
            PG8_LDB(B1, 1, 1); PG8_STAGE(PG8_SB(1, 0), b3, voffB);
            PG8_BAR; PG8_WAIT_L(0); PG8_MMA(0, 1, At, B1); PG8_BAR;
            PG8_LDA(At, 1, 1); PG8_STAGE(PG8_SA(1, 0), a3, voffA);
            PG8_BAR; PG8_WAIT_L(0); PG8_MMA(1, 0, At, B0); PG8_BAR; PG8_SCHED;
            PG8_STAGE(PG8_SB(1, 1), b3 + hstep, voffB);
            PG8_WAIT_V(6); PG8_BAR; PG8_MMA(1, 1, At, B1); PG8_BAR;
            }
        }
        if constexpr (FP8) asm volatile("s_nop 15\n\ts_nop 15" ::: "memory");
        if constexpr (ALIGN_EPI) { if (wr == 0) PG8_BAR; }
        if constexpr (!Epi::AFTER_DRAIN) { E(acc, cur, wr, wc, fr, fq); S.done(cur); }
        if (!has_next) break;
#pragma unroll
        for (int a = 0; a < 2; ++a)
#pragma unroll
            for (int b = 0; b < 2; ++b)
#pragma unroll
                for (int m = 0; m < 4; ++m)
#pragma unroll
                    for (int n = 0; n < 2; ++n) acc[a][b][m][n] = (f32x4){0.f, 0.f, 0.f, 0.f};
        cur = nxt; cA = nA; cB = nB; ++ui;
        if constexpr (ALIGN_EPI) { if (wr == 1) PG8_BAR; }
    }
    PG8_WAIT_V(0);
    if constexpr (!ALIGN_EPI) { if (wr == 0) PG8_BAR; }
    PG8_BAR;
    if constexpr (Epi::AFTER_DRAIN) { E.fused(acc, cur, wr, wc, fr, fq, lds, wid, lane); S.done(cur); }
#undef PG8_SA
#undef PG8_SB
#undef PG8_STAGE
#undef PG8_LDA
#undef PG8_LDB
#undef PG8_MMA
#undef PG8_WAIT_V
#undef PG8_WAIT_L
#undef PG8_BAR
#undef PG8_SCHED
}
}

constexpr int NB = 8, SEQ = 4096, DM = 1024, MTOK = NB * SEQ, DFF = 2816, NGU = 2 * DFF, NPROJ = 3840, NMODC = 9 * DM, WIN_COLS = 3656;
constexpr float LOG2E = 1.4426950408889634f, QSCALE = 0.125f * 1.4426950408889634f;
constexpr int PC_QA = 0, PC_KA = 256, PC_VA = 512, PC_QB = 768, PC_KB = 1024, PC_VB = 1280, PC_QC = 1536, PC_KC = 2048, PC_VC = 2560, PC_QI = 3072, PC_KI = 3584, PC_WI = 3648;
constexpr int NWAVES = 8;

constexpr size_t MiB = 1u << 20;
constexpr size_t WS_CTL = 0, CTL_ZERO_BYTES = 1 * MiB;
constexpr size_t WS_MOD = 2 * MiB;
constexpr size_t WS_W = 4 * MiB;
constexpr size_t OFF_WGU1 = 0, OFF_WD1 = OFF_WGU1 + (size_t)NGU * DM * 2, OFF_WGU2 = OFF_WD1 + (size_t)DM * DFF * 2, OFF_WD2 = OFF_WGU2 + (size_t)NGU * DM * 2,
                 OFF_WIN = OFF_WD2 + (size_t)DM * DFF * 2, OFF_WOUT = OFF_WIN + (size_t)NPROJ * DM * 2, LAYER_W_BYTES = OFF_WOUT + (size_t)DM * DM * 2;
constexpr size_t WS_H = 96 * MiB;
constexpr size_t WS_PROJ = 160 * MiB;
constexpr size_t WS_O = 400 * MiB;
constexpr size_t WS_MASK = 464 * MiB;
constexpr size_t WS_END = 480 * MiB;
static_assert(WS_W + 2 * LAYER_W_BYTES <= WS_H && WS_PROJ + (size_t)MTOK * NPROJ * 2 <= WS_O && WS_MASK + (size_t)NB * 64 * SEQ * 8 <= WS_END, "d_ws map");
constexpr int CW_BAR = 4096;
constexpr int RING_BYTES = 131072, EXTRA_OFF = RING_BYTES, LDSCTL_OFF = EXTRA_OFF + 4096, MISC_OFF = LDSCTL_OFF + 320, LDS_BYTES = 147456;

#define GAS __attribute__((address_space(1)))
#define LAS __attribute__((address_space(3)))
typedef unsigned short bf16;
typedef unsigned v4u __attribute__((ext_vector_type(4)));
typedef unsigned v2u __attribute__((ext_vector_type(2)));
typedef float f32x4 __attribute__((ext_vector_type(4)));
typedef short bf16x8 __attribute__((ext_vector_type(8)));
typedef GAS unsigned gu32;
#define LDS_WAIT() asm volatile("s_waitcnt lgkmcnt(0)" ::: "memory")
#define VM_WAIT() asm volatile("s_waitcnt vmcnt(0)" ::: "memory")
__device__ __forceinline__ unsigned pk2(float lo, float hi) { return pg8::cvt_pk_bf16(lo, hi); }
__device__ __forceinline__ float bf2f(bf16 v) { return __uint_as_float((unsigned)v << 16); }
#define XB_TMO      128
#define XB_XCNT(j)  (256  + 64 * (j))
#define XB_XSUB(j)  (1280 + 64 * (j))
#define XB_XGEN(j)  (2304 + 64 * (j))
#define XB_TOP      3328
#define XB_TOPGEN   3392
#define XCD_BAR_WORDS 3456
#define XB_SPIN_CAP (1u << 18)

__device__ __forceinline__ unsigned xb_ld(unsigned* p)              { return __hip_atomic_load(p, __ATOMIC_RELAXED, __HIP_MEMORY_SCOPE_AGENT); }
__device__ __forceinline__ unsigned xb_add(unsigned* p, unsigned v) { return __hip_atomic_fetch_add(p, v, __ATOMIC_RELAXED, __HIP_MEMORY_SCOPE_AGENT); }
__device__ __forceinline__ unsigned xb_xcc_id() { return (unsigned)__builtin_amdgcn_s_getreg((3 << 11) | 20) & 0xFu; }
#define XB_SPIN(cond, bar) do { unsigned _sp = 0; while (cond) { __builtin_amdgcn_s_sleep(1); \
    if ((++_sp & 255u) == 0u) { if (xb_ld(&(bar)[XB_TMO])) break; if (_sp > XB_SPIN_CAP) { atomicAdd(&(bar)[XB_TMO], 1u); break; } } } } while (0)

struct XcdBarrier {
    bool t0;
    unsigned* bar; unsigned x;
    volatile LAS unsigned* st;
};

__device__ __forceinline__ XcdBarrier xcd_barrier_post(unsigned* bar, volatile LAS unsigned* st) {
    XcdBarrier b; b.bar = bar; b.x = xb_xcc_id(); b.st = st; b.t0 = (threadIdx.x == 0);
    if (threadIdx.x == 0) (void)xb_add(&bar[XB_XCNT(b.x)], 1u);
    return b;
}
__device__ __forceinline__ void xcd_barrier_complete(unsigned* bar, unsigned x, unsigned& nloc, unsigned& nx) {
    const unsigned G = gridDim.x * gridDim.y * gridDim.z;
    unsigned sum, cnt, mine, sp = 0u;
    for (;;) {
        sum = 0u; cnt = 0u; mine = 0u;
#pragma unroll
        for (unsigned j = 0; j < 16; ++j) { const unsigned c = xb_ld(&bar[XB_XCNT(j)]); sum += c; cnt += (c > 0u) ? 1u : 0u; mine = (j == x) ? c : mine; }
        if (sum == G) break;
        __builtin_amdgcn_s_sleep(1);
        if ((++sp & 255u) == 0u) { if (xb_ld(&bar[XB_TMO])) break; if (sp > XB_SPIN_CAP) { atomicAdd(&bar[XB_TMO], 1u); break; } }
    }
    nloc = mine > 0u ? mine : 1u; nx = cnt > 0u ? cnt : 1u;
}

__device__ __forceinline__ void xcd_barrier(const XcdBarrier& b) {
    asm volatile("s_waitcnt vmcnt(0)" ::: "memory");
    __syncthreads();
    if (b.t0) {
        unsigned* bar = b.bar;
        __builtin_amdgcn_s_waitcnt(0);
        unsigned nloc = b.st[0], nx = b.st[1];
        if (nloc == 0u) { xcd_barrier_complete(bar, b.x, nloc, nx); b.st[0] = nloc; b.st[1] = nx; }
        const unsigned old = xb_add(&bar[XB_XSUB(b.x)], 1u);
        const unsigned gen = old / nloc;
        if (old + 1u == (gen + 1u) * nloc) {
            __builtin_amdgcn_fence(__ATOMIC_RELEASE, "agent");
            asm volatile("s_waitcnt vmcnt(0)" ::: "memory");
            const unsigned og = xb_add(&bar[XB_TOP], 1u);
            const unsigned tg = og / nx;
            if (og + 1u == (tg + 1u) * nx) xb_add(&bar[XB_TOPGEN], 1u);
            else XB_SPIN(xb_ld(&bar[XB_TOPGEN]) == tg, bar);
            __builtin_amdgcn_fence(__ATOMIC_ACQUIRE, "agent");
            xb_add(&bar[XB_XGEN(b.x)], 1u);
            asm volatile("s_waitcnt vmcnt(0)" ::: "memory");
        } else {
            XB_SPIN(xb_ld(&bar[XB_XGEN(b.x)]) == gen, bar);
            __builtin_amdgcn_fence(__ATOMIC_ACQUIRE, "agent");
            asm volatile("s_waitcnt vmcnt(0)" ::: "memory");
        }
    }
    __syncthreads();
}

struct Frame {
    LAS unsigned char* lds;
    int tid, lane, wave;
    int vcu, G, bid;
};
__device__ __forceinline__ float wave_sum(float v) { return pg8::wave_sum_f(v); }

template <bool F8>
__device__ __forceinline__ void transpose_item(const float* W, int ldw, int c0, int ncols, int K, int kb, void* WTv, int dst_row0, const float* kscale, LAS float* scr, int lane) {
    const int k0 = 64 * kb, n = lane & 31;
#pragma unroll 8
    for (int i = 0; i < 32; ++i) { const int kk = 2 * i + (lane >> 5);
        float v = 0.f;
        if (n < ncols) { v = W[(size_t)(k0 + kk) * ldw + c0 + n]; if (kscale) v *= kscale[k0 + kk]; }
        scr[kk * 33 + n] = v; }
    LDS_WAIT(); asm volatile("" ::: "memory");
    const int c = lane & 7;
#pragma unroll
    for (int j = 0; j < 4; ++j) { const int nn = (lane >> 3) + 8 * j; const LAS float* s = scr + (8 * c) * 33 + nn;
        if constexpr (F8) {
            v2u o; o.x = pg8::pk4_fp8(32.f * s[0 * 33], 32.f * s[1 * 33], 32.f * s[2 * 33], 32.f * s[3 * 33]); o.y = pg8::pk4_fp8(32.f * s[4 * 33], 32.f * s[5 * 33], 32.f * s[6 * 33], 32.f * s[7 * 33]);
            *(GAS v2u*)((unsigned char*)WTv + (size_t)(dst_row0 + nn) * K + k0 + 8 * c) = o;
        } else { bf16* WT = (bf16*)WTv;
            v4u o; o.x = pk2(s[0 * 33], s[1 * 33]); o.y = pk2(s[2 * 33], s[3 * 33]); o.z = pk2(s[4 * 33], s[5 * 33]); o.w = pk2(s[6 * 33], s[7 * 33]);
            *(GAS v4u*)(WT + (size_t)(dst_row0 + nn) * K + k0 + 8 * c) = o; } }
    LDS_WAIT(); asm volatile("" ::: "memory");
}
struct Ptrs {
    const float *x, *c, *w_ada, *b_ada, *norm_ffn1, *w_gate1, *w_up1, *w_down1, *norm_mix, *w_in, *qn_a, *kn_a, *qn_c, *kn_c, *g_out, *w_out, *norm_ffn2, *w_gate2, *w_up2, *w_down2;
    float* out; unsigned char* ws; int ph_lo, ph_hi;
};
constexpr int IT_GU = (NGU / 32) * (DM / 64), IT_D = (DM / 32) * (DFF / 64), IT_IN = (NPROJ / 32) * (DM / 64), IT_OUT = (DM / 32) * (DM / 64);
constexpr int IT_LAYER = 2 * IT_GU + 2 * IT_D + IT_IN + IT_OUT;
template <class KP>
__device__ __forceinline__ void p0_prologue(Frame& F, KP P) {
    {
        LAS float* sl = (LAS float*)F.lds;
        LAS float* part = (LAS float*)(F.lds + 32768);
        float* mod = (float*)(P->ws + WS_MOD);
        for (int it = F.bid; it < 72; it += F.G) {
            const int l = it / 36, cb = it % 36;
            for (int i = F.tid; i < NB * DM; i += NWAVES * 64) { const float cv = P->c[i]; sl[i] = cv / (1.0f + __expf(-cv)); }
            __syncthreads();
            f32x4 acc[NB];
#pragma unroll
            for (int b = 0; b < NB; ++b) acc[b] = (f32x4){0.f, 0.f, 0.f, 0.f};
            const float* wp = P->w_ada + (size_t)l * DM * NMODC + 256 * cb + 4 * F.lane;
#pragma unroll 4
            for (int kk = 0; kk < 128; ++kk) { const int k = 128 * F.wave + kk; const f32x4 wv = *(const GAS f32x4*)(wp + (size_t)k * NMODC);
#pragma unroll
                for (int b = 0; b < NB; ++b) acc[b] += wv * sl[b * DM + k]; }
#pragma unroll
            for (int b = 0; b < NB; ++b) *(LAS f32x4*)(part + (F.wave * NB + b) * 256 + 4 * F.lane) = acc[b];
            __syncthreads();
            for (int o = F.tid; o < NB * 256; o += NWAVES * 64) { const int b = o >> 8, col = o & 255; float s = P->b_ada[l * NMODC + 256 * cb + col];
#pragma unroll
                for (int w = 0; w < NWAVES; ++w) s += part[(w * NB + b) * 256 + col];
                mod[(size_t)(l * NB + b) * NMODC + 256 * cb + col] = s; }
            __syncthreads();
        }
    }
    LAS float* scr = (LAS float*)(F.lds + F.wave * 16384);
    const int gw = F.vcu * NWAVES + F.wave, NGW = F.G * NWAVES;
    for (int it0 = gw; it0 < 2 * IT_LAYER; it0 += NGW) {
        const int l = it0 / IT_LAYER; int it = it0 % IT_LAYER;
        unsigned char* wl = P->ws + WS_W + (size_t)l * LAYER_W_BYTES;
        if (it < 2 * (IT_GU + IT_D)) {
            const int f2 = it >= (IT_GU + IT_D); if (f2) it -= IT_GU + IT_D;
            const float* wg = (f2 ? P->w_gate2 : P->w_gate1) + (size_t)l * DM * DFF; const float* wu = (f2 ? P->w_up2 : P->w_up1) + (size_t)l * DM * DFF;
            const float* wd = (f2 ? P->w_down2 : P->w_down1) + (size_t)l * DFF * DM;
            if (it < IT_GU) { const int g = it / (DM / 64), kb = it % (DM / 64), pn = g >> 3, sub = g & 7;
                transpose_item<true>(sub < 4 ? wg : wu, DFF, 128 * pn + 32 * (sub & 3), 32, DM, kb, wl + (f2 ? OFF_WGU2 : OFF_WGU1), 32 * g, nullptr, scr, F.lane); }
            else { it -= IT_GU; const int g = it / (DFF / 64), kb = it % (DFF / 64);
                transpose_item<true>(wd, DM, 32 * g, 32, DFF, kb, wl + (f2 ? OFF_WD2 : OFF_WD1), 32 * g, nullptr, scr, F.lane); }
            continue;
        }
        it -= 2 * (IT_GU + IT_D);
        if (it < IT_IN) { const int g = it / (DM / 64), kb = it % (DM / 64), pn = g >> 3, sub = g & 7, bj = sub >> 2, wc = sub & 3, pc0 = 256 * pn + 64 * wc + 32 * bj;
            int c0 = 0, nc = 32;
            if (pc0 < 768) c0 = pc0; else if (pc0 < 1536) c0 = pc0 - 768 + 1352; else if (pc0 < 3072) c0 = pc0 - 1536 + 2120; else if (pc0 < 3584) c0 = pc0 - 3072 + 768;
            else if (pc0 < 3648) c0 = pc0 - 3584 + 1280; else if (pc0 == 3648) { c0 = 1344; nc = 8; } else nc = 0;
            transpose_item<false>(P->w_in + (size_t)l * DM * WIN_COLS, WIN_COLS, c0, nc, DM, kb, wl + OFF_WIN, 32 * g, nullptr, scr, F.lane);
            continue; }
        it -= IT_IN;
        { const int g = it / (DM / 64), kb = it % (DM / 64);
          transpose_item<false>(P->w_out + (size_t)l * DM * DM, DM, 32 * g, 32, DM, kb, wl + OFF_WOUT, 32 * g, P->g_out + l * DM, scr, F.lane); }
    }
}

template <bool F8OUT>
__device__ __forceinline__ void norm_mod_phase(Frame& F, const float* xsrc, const float* gain, const float* modl, int ch_shift, int ch_scale, void* houtv) {
    for (int rb = F.bid; rb < MTOK / 128; rb += F.G) {
        const int b = rb >> 5;
        const float* shp = modl + (size_t)b * NMODC + ch_shift * DM; const float* scp = modl + (size_t)b * NMODC + ch_scale * DM;
        f32x4 ga[4], sh[4];
#pragma unroll
        for (int j = 0; j < 4; ++j) { const int col = 4 * F.lane + 256 * j; const f32x4 g = *(const GAS f32x4*)(gain + col), s = *(const GAS f32x4*)(scp + col);
            ga[j] = g * (s + 1.0f); sh[j] = *(const GAS f32x4*)(shp + col); }
        for (int rr = 0; rr < 16; ++rr) { const int row = 128 * rb + 16 * F.wave + rr;
            const GAS f32x4* xr = (const GAS f32x4*)(xsrc + (size_t)row * DM) + F.lane;
            f32x4 v[4]; float ss = 0.f;
#pragma unroll
            for (int j = 0; j < 4; ++j) { v[j] = xr[64 * j]; ss += (v[j].x * v[j].x + v[j].y * v[j].y) + (v[j].z * v[j].z + v[j].w * v[j].w); }
            const float rstd = 1.0f / sqrtf(wave_sum(ss) * (1.0f / DM) + 1e-6f);
            if constexpr (F8OUT) { GAS unsigned* o4 = (GAS unsigned*)((unsigned char*)houtv + (size_t)row * DM) + F.lane;
#pragma unroll
                for (int j = 0; j < 4; ++j) { const f32x4 y = v[j] * rstd * ga[j] + sh[j]; o4[64 * j] = pg8::pk4_fp8(y.x, y.y, y.z, y.w); } }
            else { GAS v2u* o8 = (GAS v2u*)((bf16*)houtv + (size_t)row * DM) + F.lane;
#pragma unroll
                for (int j = 0; j < 4; ++j) { const f32x4 y = v[j] * rstd * ga[j] + sh[j]; v2u w; w.x = pk2(y.x, y.y); w.y = pk2(y.z, y.w); o8[64 * j] = w; } }
        }
    }
}
__device__ __forceinline__ void group_norm_phase(Frame& F, const bf16* o, bf16* y) {
    const int gw = F.bid * NWAVES + F.wave, NGW = F.G * NWAVES;
    for (int row = gw; row < MTOK; row += NGW) {
        const GAS v2u* orow = (const GAS v2u*)(o + (size_t)row * DM) + F.lane;
        float v[4][4], ss[4];
#pragma unroll
        for (int j = 0; j < 4; ++j) { const v2u w = orow[64 * j]; v[j][0] = __uint_as_float(w.x << 16); v[j][1] = __uint_as_float(w.x & 0xffff0000u); v[j][2] = __uint_as_float(w.y << 16); v[j][3] = __uint_as_float(w.y & 0xffff0000u);
            ss[j] = wave_sum((v[j][0] * v[j][0] + v[j][1] * v[j][1]) + (v[j][2] * v[j][2] + v[j][3] * v[j][3])); }
        float rs[4];
        rs[0] = 1.0f / sqrtf(ss[0] * (1.0f / 256.f) + 1e-6f); rs[1] = 1.0f / sqrtf(ss[1] * (1.0f / 256.f) + 1e-6f); rs[2] = rs[3] = 1.0f / sqrtf((ss[2] + ss[3]) * (1.0f / 512.f) + 1e-6f);
        GAS v2u* yrow = (GAS v2u*)(y + (size_t)row * DM) + F.lane;
#pragma unroll
        for (int j = 0; j < 4; ++j) { v2u w; w.x = pk2(v[j][0] * rs[j], v[j][1] * rs[j]); w.y = pk2(v[j][2] * rs[j], v[j][3] * rs[j]); yrow[64 * j] = w; }
    }
}

namespace att {
typedef float f32x16 __attribute__((ext_vector_type(16)));
typedef short s16x4 __attribute__((ext_vector_type(4)));
__device__ __forceinline__ int crow(int r, int hi) { return (r & 3) + 8 * (r >> 2) + 4 * hi; }
#define SBAR() __builtin_amdgcn_sched_barrier(0)
__device__ __forceinline__ void pv(f32x16* o, int vb, bf16x8 pa0, bf16x8 pa1, bf16x8 pa2, bf16x8 pa3) {
#pragma unroll
    for (int d0 = 0; d0 < 2; ++d0) { s16x4 lo[4], hi[4];
#pragma unroll
        for (int ks = 0; ks < 4; ++ks) {
            asm volatile("ds_read_b64_tr_b16 %0,%1 offset:%c2" : "=&v"(lo[ks]) : "v"(vb), "i"(d0 * 4096 + ks * 1024) : "memory");
            asm volatile("ds_read_b64_tr_b16 %0,%1 offset:%c2" : "=&v"(hi[ks]) : "v"(vb), "i"(d0 * 4096 + ks * 1024 + 512) : "memory"); }
        asm volatile("s_waitcnt lgkmcnt(0)" ::: "memory"); SBAR();
#define PK(k) (bf16x8){lo[k][0], lo[k][1], lo[k][2], lo[k][3], hi[k][0], hi[k][1], hi[k][2], hi[k][3]}
        o[d0] = __builtin_amdgcn_mfma_f32_32x32x16_bf16(pa0, PK(0), o[d0], 0, 0, 0);
        o[d0] = __builtin_amdgcn_mfma_f32_32x32x16_bf16(pa1, PK(1), o[d0], 0, 0, 0);
        o[d0] = __builtin_amdgcn_mfma_f32_32x32x16_bf16(pa2, PK(2), o[d0], 0, 0, 0);
        o[d0] = __builtin_amdgcn_mfma_f32_32x32x16_bf16(pa3, PK(3), o[d0], 0, 0, 0);
#undef PK
    }
}
__device__ __forceinline__ void qkt(f32x16& p0, f32x16& p1, const bf16x8 (&kf)[8], const bf16x8 (&qr)[4]) {
    p0 = (f32x16){}; p1 = (f32x16){};
#pragma unroll
    for (int d0 = 0; d0 < 4; ++d0) { p0 = __builtin_amdgcn_mfma_f32_32x32x16_bf16(kf[2 * d0], qr[d0], p0, 0, 0, 0); p1 = __builtin_amdgcn_mfma_f32_32x32x16_bf16(kf[2 * d0 + 1], qr[d0], p1, 0, 0, 0); }
}
__device__ __forceinline__ void load_k(bf16x8 (&kf)[8], const bf16* k0, const bf16* k1) {
#pragma unroll
    for (int d0 = 0; d0 < 4; ++d0) { kf[2 * d0] = *(const GAS bf16x8*)(k0 + 16 * d0); kf[2 * d0 + 1] = *(const GAS bf16x8*)(k1 + 16 * d0); }
}
__device__ __forceinline__ void stage_v(const bf16* v0, const bf16* v1, const bf16* v2, const bf16* v3, LAS unsigned char* slot) {
    const bf16* vg[4] = {v0, v1, v2, v3};
#pragma unroll
    for (int dh = 0; dh < 2; ++dh)
#pragma unroll
        for (int kg = 0; kg < 4; ++kg)
            __builtin_amdgcn_global_load_lds((const unsigned*)(vg[kg] + dh * 32), (LAS unsigned*)(slot + (dh * 4 + kg) * 1024), 16, 0, 0);
}
__device__ __forceinline__ float swap_max(float m) { auto rr = __builtin_amdgcn_permlane32_swap(__float_as_uint(m), __float_as_uint(m), false, false); return fmaxf(__uint_as_float(rr[0]), __uint_as_float(rr[1])); }
__device__ __forceinline__ float swap_sum(float m) { auto rr = __builtin_amdgcn_permlane32_swap(__float_as_uint(m), __float_as_uint(m), false, false); return __uint_as_float(rr[0]) + __uint_as_float(rr[1]); }
__device__ __forceinline__ float rowmax32(const f32x16& p0, const f32x16& p1) {
    float a = fmaxf(p0[0], p1[0]);
#pragma unroll
    for (int r = 1; r < 16; ++r) a = fmaxf(a, fmaxf(p0[r], p1[r]));
    return swap_max(a);
}
__device__ __forceinline__ void scale_rows(f32x16 (&o)[2], LAS float* wsf, float f, int r32, int hi) {
    if (hi == 0) wsf[r32] = f;
#pragma unroll
    for (int r = 0; r < 16; ++r) { const float fr = wsf[crow(r, hi)]; o[0][r] *= fr; o[1][r] *= fr; }
}
#define PACK4(P, B) (v4u){pk2(P[B], P[B + 1]), pk2(P[B + 2], P[B + 3]), pk2(P[B + 4], P[B + 5]), pk2(P[B + 6], P[B + 7])}
__device__ __forceinline__ void softmax_step(f32x16& p0, f32x16& p1, float& m, float& lsum, f32x16 (&o)[2], LAS float* wsf, int r32, int hi) {
    const float rm = rowmax32(p0, p1), mnew = fmaxf(m, rm);
    if (__any(mnew > m)) { const float f = __builtin_amdgcn_exp2f(m - mnew); lsum *= f; scale_rows(o, wsf, f, r32, hi); m = mnew; }
    float s = 0.f;
#pragma unroll
    for (int r = 0; r < 16; ++r) { p0[r] = __builtin_amdgcn_exp2f(p0[r] - m); p1[r] = __builtin_amdgcn_exp2f(p1[r] - m); s += p0[r] + p1[r]; }
    lsum += s;
}
__device__ __forceinline__ void pv_tile(f32x16 (&o)[2], const f32x16& p0, const f32x16& p1, int vb) {
    const v4u w0 = PACK4(p0, 0), w1 = PACK4(p0, 8), w2 = PACK4(p1, 0), w3 = PACK4(p1, 8);
    asm volatile("s_waitcnt vmcnt(0)" ::: "memory");
    pv(o, vb, __builtin_bit_cast(bf16x8, w0), __builtin_bit_cast(bf16x8, w1), __builtin_bit_cast(bf16x8, w2), __builtin_bit_cast(bf16x8, w3));
}
struct WaveCtx { int lane, r32, hi, wid; LAS unsigned char* vslot; LAS float* wsf; int vb; };
__device__ __forceinline__ WaveCtx make_ctx(LAS unsigned char* lds, int slot_stride, int wave_id) {
    int lane_o = (int)__builtin_amdgcn_mbcnt_hi(~0u, __builtin_amdgcn_mbcnt_lo(~0u, 0u)); asm volatile("" : "+v"(lane_o));
    WaveCtx c; c.lane = lane_o; c.r32 = c.lane & 31; c.hi = c.lane >> 5; c.wid = wave_id;
    c.vslot = lds + c.wid * slot_stride; c.wsf = (LAS float*)(lds + EXTRA_OFF + 2048 + c.wid * 256);
    c.vb = (int)(unsigned)(uintptr_t)c.vslot + ((c.lane >> 4) & 1) * 32 + (c.lane & 3) * 8 + (4 * c.hi + ((c.lane & 15) >> 2)) * 64;
    return c;
}
__device__ __forceinline__ void store_o(const f32x16 (&o)[2], const WaveCtx& c, bf16* obuf, size_t row0, int col0, bool use_scale) {
#pragma unroll
    for (int r = 0; r < 16; ++r) { const int q = crow(r, c.hi); const float f = use_scale ? c.wsf[q] : 1.0f;
        bf16* op = obuf + (row0 + q) * DM + col0 + c.r32;
        op[0] = (bf16)(pk2(o[0][r] * f, 0.f) & 0xffffu); op[32] = (bf16)(pk2(o[1][r] * f, 0.f) & 0xffffu); }
}

__device__ __forceinline__ void attA_unit(int b, int h, int qb, const bf16* proj, const unsigned long long* maskw, bf16* obuf, LAS unsigned char* lds, float slope2, int wave_id) {
    const WaveCtx c = make_ctx(lds, 16384, wave_id);
    const int tq0 = 256 * qb + 32 * c.wid, t = tq0 + c.r32;
    const size_t rowbase = (size_t)b * SEQ;
    bf16x8 qr[4];
    { const bf16* Qp = proj + (rowbase + t) * NPROJ + PC_QA + h * 64 + c.hi * 8;
#pragma unroll
      for (int d0 = 0; d0 < 4; ++d0) qr[d0] = *(const GAS bf16x8*)(Qp + 16 * d0); }
    const bf16* Kh = proj + (rowbase + c.r32) * NPROJ + PC_KA + h * 64 + c.hi * 8;
    const bf16* Vh = proj + (rowbase + (c.lane >> 2)) * NPROJ + PC_VA + h * 64 + (c.lane & 3) * 8;
    const unsigned long long* mwp = maskw + (size_t)b * 64 * SEQ + t;
    const int njt = (tq0 + 31) / 64 + 1;
    float m = -1e30f, lsum = 0.f; f32x16 o[2]; o[0] = (f32x16){}; o[1] = (f32x16){};
    bf16x8 kf[8], kn[8]; unsigned long long mw, mwn = 0ull;
    load_k(kf, Kh, Kh + (size_t)32 * NPROJ); stage_v(Vh, Vh + (size_t)16 * NPROJ, Vh + (size_t)32 * NPROJ, Vh + (size_t)48 * NPROJ, c.vslot); mw = mwp[0];
    for (int j = 0; j < njt; ++j) {
        const bool more = (j + 1 < njt);
        if (more) {
            const bf16* kt = Kh + (size_t)(64 * (j + 1)) * NPROJ; load_k(kn, kt, kt + (size_t)32 * NPROJ);
            const bf16* vt = Vh + (size_t)(64 * (j + 1)) * NPROJ; stage_v(vt, vt + (size_t)16 * NPROJ, vt + (size_t)32 * NPROJ, vt + (size_t)48 * NPROJ, c.vslot + ((j + 1) & 1) * 8192);
            mwn = mwp[(size_t)(j + 1) * SEQ]; }
        f32x16 p0, p1; qkt(p0, p1, kf, qr);
        const float base = slope2 * (float)(64 * j + 4 * c.hi - t);
        const unsigned wl = (unsigned)mw >> (4 * c.hi), wh = (unsigned)(mw >> 32) >> (4 * c.hi);
#pragma unroll
        for (int r = 0; r < 16; ++r) { const int cr = (r & 3) + 8 * (r >> 2);
            const float x0 = p0[r] + (base + slope2 * (float)cr), x1 = p1[r] + (base + slope2 * (float)(cr + 32));
            p0[r] = ((wl >> cr) & 1u) ? x0 : -INFINITY; p1[r] = ((wh >> cr) & 1u) ? x1 : -INFINITY; }
        softmax_step(p0, p1, m, lsum, o, c.wsf, c.r32, c.hi);
        pv_tile(o, p0, p1, c.vb + (j & 1) * 8192);
        if (more) {
#pragma unroll
            for (int i = 0; i < 8; ++i) kf[i] = kn[i];
            mw = mwn; }
    }
    const float l = swap_sum(lsum);
    if (c.hi == 0) c.wsf[c.r32] = 1.0f / l;
    store_o(o, c, obuf, rowbase + tq0, h * 64, true);
}

__device__ __forceinline__ void attB_unit(int b, int h, int qb, const bf16* proj, bf16* obuf, LAS unsigned char* lds, int wave_id) {
    const WaveCtx c = make_ctx(lds, 16384, wave_id);
    const int tq0 = 256 * qb + 32 * c.wid, t = tq0 + c.r32;
    const size_t rowbase = (size_t)b * SEQ;
    bf16x8 qr[4];
    { const bf16* Qp = proj + (rowbase + t) * NPROJ + PC_QB + h * 64 + c.hi * 8;
#pragma unroll
      for (int d0 = 0; d0 < 4; ++d0) qr[d0] = *(const GAS bf16x8*)(Qp + 16 * d0); }
    const bf16* Kh = proj + (rowbase + c.r32) * NPROJ + PC_KB + h * 64 + c.hi * 8;
    const bf16* Vh = proj + (rowbase + (c.lane >> 2)) * NPROJ + PC_VB + h * 64 + (c.lane & 3) * 8;
    const int jd = tq0 >> 6;
    float R = 0.f; f32x16 o[2]; o[0] = (f32x16){}; o[1] = (f32x16){};
    bf16x8 kf[8], kn[8];
    { const bf16* kt = Kh + (size_t)(64 * jd) * NPROJ; load_k(kf, kt, kt + (size_t)32 * NPROJ);
      const bf16* vt = Vh + (size_t)(64 * jd) * NPROJ; stage_v(vt, vt + (size_t)16 * NPROJ, vt + (size_t)32 * NPROJ, vt + (size_t)48 * NPROJ, c.vslot + (jd & 1) * 8192); }
    for (int j = jd; j >= 0; --j) {
        const bool more = (j > 0);
        if (more) { const bf16* kt = Kh + (size_t)(64 * (j - 1)) * NPROJ; load_k(kn, kt, kt + (size_t)32 * NPROJ);
            const bf16* vt = Vh + (size_t)(64 * (j - 1)) * NPROJ; stage_v(vt, vt + (size_t)16 * NPROJ, vt + (size_t)32 * NPROJ, vt + (size_t)48 * NPROJ, c.vslot + ((j - 1) & 1) * 8192); }
        f32x16 z0, z1; qkt(z0, z1, kf, qr);
        f32x16 L0, L1;
#pragma unroll
        for (int r = 0; r < 16; ++r) {
            L0[r] = -(fmaxf(z0[r], 0.f) + __builtin_amdgcn_logf(1.0f + __builtin_amdgcn_exp2f(-fabsf(z0[r]))));
            L1[r] = -(fmaxf(z1[r], 0.f) + __builtin_amdgcn_logf(1.0f + __builtin_amdgcn_exp2f(-fabsf(z1[r])))); }
        const bool diag = (j == jd);
        if (diag) {
#pragma unroll
            for (int r = 0; r < 16; ++r) { const int s = 64 * j + crow(r, c.hi); if (!(s < t)) L0[r] = 0.f; if (!(s + 32 < t)) L1[r] = 0.f; }
        }
        float gs[8], T[8], pr[8];
#pragma unroll
        for (int k = 0; k < 4; ++k) { gs[k] = (L0[4 * k] + L0[4 * k + 1]) + (L0[4 * k + 2] + L0[4 * k + 3]); gs[k + 4] = (L1[4 * k] + L1[4 * k + 1]) + (L1[4 * k + 2] + L1[4 * k + 3]); }
#pragma unroll
        for (int k = 0; k < 8; ++k) { auto rr = __builtin_amdgcn_permlane32_swap(__float_as_uint(gs[k]), __float_as_uint(gs[k]), false, false);
            const float lo = __uint_as_float(rr[0]), hv = __uint_as_float(rr[1]); T[k] = lo + hv; pr[k] = c.hi ? lo : hv; }
        float ST = 0.f;
#pragma unroll
        for (int k = 7; k >= 0; --k) {
            const float E = R + ST + (c.hi == 0 ? pr[k] : 0.f);
            if (k >= 4) { const int b4 = 4 * (k - 4);
                const float c3 = E, c2 = c3 + L1[b4 + 3], c1 = c2 + L1[b4 + 2], c0 = c1 + L1[b4 + 1];
                z1[b4 + 3] = __builtin_amdgcn_exp2f(z1[b4 + 3] + L1[b4 + 3] + c3); z1[b4 + 2] = __builtin_amdgcn_exp2f(z1[b4 + 2] + L1[b4 + 2] + c2);
                z1[b4 + 1] = __builtin_amdgcn_exp2f(z1[b4 + 1] + L1[b4 + 1] + c1); z1[b4] = __builtin_amdgcn_exp2f(z1[b4] + L1[b4] + c0);
            } else { const int b4 = 4 * k;
                const float c3 = E, c2 = c3 + L0[b4 + 3], c1 = c2 + L0[b4 + 2], c0 = c1 + L0[b4 + 1];
                z0[b4 + 3] = __builtin_amdgcn_exp2f(z0[b4 + 3] + L0[b4 + 3] + c3); z0[b4 + 2] = __builtin_amdgcn_exp2f(z0[b4 + 2] + L0[b4 + 2] + c2);
                z0[b4 + 1] = __builtin_amdgcn_exp2f(z0[b4 + 1] + L0[b4 + 1] + c1); z0[b4] = __builtin_amdgcn_exp2f(z0[b4] + L0[b4] + c0);
            }
            ST += T[k];
        }
        R += ST;
        if (diag) {
#pragma unroll
            for (int r = 0; r < 16; ++r) { const int s = 64 * j + crow(r, c.hi); if (!(s < t)) z0[r] = 0.f; if (!(s + 32 < t)) z1[r] = 0.f; }
        }
        pv_tile(o, z0, z1, c.vb + (j & 1) * 8192);
        if (__all(R < -150.0f)) break;
        if (more) {
#pragma unroll
            for (int i = 0; i < 8; ++i) kf[i] = kn[i]; }
    }
    asm volatile("s_waitcnt vmcnt(0)" ::: "memory");
    store_o(o, c, obuf, rowbase + tq0, 256 + h * 64, false);
}

__device__ __forceinline__ void attC_unit(int b, int h, int blk, const bf16* proj, bf16* obuf, LAS unsigned char* lds, float slope2, int wave_id) {
    const WaveCtx c = make_ctx(lds, 8192, wave_id);
    LAS bf16* oacc = (LAS bf16*)(lds + 65536); LAS float* lse = (LAS float*)(lds + EXTRA_OFF);
    const int T0 = 512 * blk; const size_t rowbase = (size_t)b * SEQ;
    const bf16* Kb = proj + rowbase * NPROJ + PC_KC + h * 64 + c.hi * 8;
    const bf16* Vb = proj + rowbase * NPROJ + PC_VC + h * 64 + (c.lane & 3) * 8;
#pragma unroll 1
    for (int br = 0; br < 3; ++br) {
        const int sh = 2 * br; const float sl2 = slope2 * (float)(1 << sh);
#pragma unroll 1
        for (int jj = 0; jj < 2; ++jj) {
            const int jt = c.wid + 8 * jj;
            int cc, u0;
            if (br == 0) { cc = 0; u0 = T0 + 32 * jt; } else if (br == 1) { cc = jt & 3; u0 = (T0 >> 2) + 32 * (jt >> 2); } else { cc = jt; u0 = T0 >> 4; }
            const int qu = u0 + c.r32, t = cc + (qu << sh);
            bf16x8 qr[4];
            { const bf16* Qp = proj + (rowbase + t) * NPROJ + PC_QC + h * 64 + c.hi * 8;
#pragma unroll
              for (int d0 = 0; d0 < 4; ++d0) qr[d0] = *(const GAS bf16x8*)(Qp + 16 * d0); }
            float m = -1e30f, lsum = 0.f; f32x16 o[2]; o[0] = (f32x16){}; o[1] = (f32x16){};
            const int kt0 = (u0 - 160 + 63 >= 0) ? 0 : ((u0 - 96 + 63 >= 0) ? 1 : 2);
            bf16x8 kf[8], kn[8];
            { const int ka = u0 - 160 + 64 * kt0 + c.r32, kb2 = ka + 32; load_k(kf, Kb + (size_t)(cc + ((ka < 0 ? 0 : ka) << sh)) * NPROJ, Kb + (size_t)(cc + ((kb2 < 0 ? 0 : kb2) << sh)) * NPROJ); }
#pragma unroll 1
            for (int kt = kt0; kt < 3; ++kt) {
                const int ku0 = u0 - 160 + 64 * kt;
                { const bf16* vg[4];
#pragma unroll
                  for (int kg = 0; kg < 4; ++kg) { const int kv = ku0 + 16 * kg + (c.lane >> 2); vg[kg] = Vb + (size_t)(cc + ((kv < 0 ? 0 : kv) << sh)) * NPROJ; }
                  stage_v(vg[0], vg[1], vg[2], vg[3], c.vslot); }
                if (kt < 2) { const int ka = ku0 + 64 + c.r32, kb2 = ka + 32; load_k(kn, Kb + (size_t)(cc + ((ka < 0 ? 0 : ka) << sh)) * NPROJ, Kb + (size_t)(cc + ((kb2 < 0 ? 0 : kb2) << sh)) * NPROJ); }
                f32x16 p0, p1; qkt(p0, p1, kf, qr);
#pragma unroll
                for (int r = 0; r < 16; ++r) { const int k0 = ku0 + crow(r, c.hi), k1 = k0 + 32, d0 = qu - k0, d1 = qu - k1;
                    p0[r] = (k0 >= 0 && d0 >= 0 && d0 <= 128) ? p0[r] - sl2 * (float)d0 : -INFINITY;
                    p1[r] = (k1 >= 0 && d1 >= 0 && d1 <= 128) ? p1[r] - sl2 * (float)d1 : -INFINITY; }
                softmax_step(p0, p1, m, lsum, o, c.wsf, c.r32, c.hi);
                pv_tile(o, p0, p1, c.vb);
                if (kt < 2) {
#pragma unroll
                    for (int i = 0; i < 8; ++i) kf[i] = kn[i]; }
            }
            const float l = swap_sum(lsum), lb = m + __builtin_amdgcn_logf(l);
            const int tl = t - T0;
            if (c.hi == 0) { c.wsf[c.r32] = 1.0f / l; c.wsf[32 + c.r32] = lb; }
            float lnew = lb;
            if (br > 0) { const float lo = lse[tl], mx = fmaxf(lo, lb); lnew = mx + __builtin_amdgcn_logf(__builtin_amdgcn_exp2f(lo - mx) + __builtin_amdgcn_exp2f(lb - mx)); }
#pragma unroll
            for (int r = 0; r < 16; ++r) { const int q = crow(r, c.hi); const int tlr = cc + ((u0 + q) << sh) - T0;
                const float inv = c.wsf[q]; float v0 = o[0][r] * inv, v1 = o[1][r] * inv;
                if (br > 0) { const float lbr = c.wsf[32 + q], lo = lse[tlr], mx = fmaxf(lo, lbr), eo = __builtin_amdgcn_exp2f(lo - mx), eb = __builtin_amdgcn_exp2f(lbr - mx), rd = 1.0f / (eo + eb);
                    const float wo = eo * rd, wb = eb * rd;
                    v0 = wo * bf2f(oacc[tlr * 64 + c.r32]) + wb * v0; v1 = wo * bf2f(oacc[tlr * 64 + 32 + c.r32]) + wb * v1; }
                if (br < 2) { oacc[tlr * 64 + c.r32] = (bf16)(pk2(v0, 0.f) & 0xffffu); oacc[tlr * 64 + 32 + c.r32] = (bf16)(pk2(v1, 0.f) & 0xffffu); }
                else { bf16* op = obuf + (rowbase + T0 + tlr) * DM + 512 + h * 64 + c.r32; op[0] = (bf16)(pk2(v0, 0.f) & 0xffffu); op[32] = (bf16)(pk2(v1, 0.f) & 0xffffu); }
            }
            LDS_WAIT();
            if (br < 2 && c.hi == 0) lse[tl] = lnew;
        }
        __syncthreads();
    }
}
#undef SBAR
}

__device__ __forceinline__ int wave_sum_dpp(int v) {
    v += __builtin_amdgcn_update_dpp(0, v, 0xB1, 0xF, 0xF, true);
    v += __builtin_amdgcn_update_dpp(0, v, 0x4E, 0xF, 0xF, true);
    v += __builtin_amdgcn_update_dpp(0, v, 0x141, 0xF, 0xF, true);
    v += __builtin_amdgcn_update_dpp(0, v, 0x140, 0xF, 0xF, true);
    return __builtin_amdgcn_readlane(v, 0) + __builtin_amdgcn_readlane(v, 16) + __builtin_amdgcn_readlane(v, 32) + __builtin_amdgcn_readlane(v, 48);
}
#define IDX_COUNT_GE(G, OUT) do { unsigned cl_ = 0u; const unsigned g_ = (G); \
    _Pragma("unroll") for (int gq = 0; gq < 8; ++gq) if (8 * gq < nreg) { \
        _Pragma("unroll") for (int jq = 0; jq < 8; ++jq) cl_ += (x[8 * gq + jq] >= g_) ? 1u : 0u; } \
    OUT = wave_sum_dpp((int)cl_); } while (0)
__device__ __forceinline__ void idx_unit(Frame& F, int b, int qg, const bf16* proj, unsigned long long* maskw, unsigned& prev_tau) {
    typedef float f32x16 __attribute__((ext_vector_type(16)));
    LAS unsigned* sc = (LAS unsigned*)F.lds;
    const int lane = F.lane, r32 = lane & 31, hi = lane >> 5, wid = F.wave;
    LAS unsigned* candl = (LAS unsigned*)(F.lds + EXTRA_OFF + 2048 + wid * 256);
    const int t0 = 8 * qg; const size_t rowbase = (size_t)b * SEQ;
#ifndef IDX_REP_SCORE
#define IDX_REP_SCORE 1
#endif
#ifndef IDX_REP_SEL
#define IDX_REP_SEL 1
#endif
    _Pragma("unroll 1") for (int rep_s = 0; rep_s < IDX_REP_SCORE; ++rep_s)
    if (t0 + 7 >= 256) {
        const int ntile = (t0 + 8 + 31) / 32;
        bf16x8 qf[2][4]; float wv[2][16];
#pragma unroll
        for (int rt = 0; rt < 2; ++rt) { const bf16* qp = proj + (rowbase + t0 + 4 * rt + (r32 >> 3)) * NPROJ + PC_QI + (r32 & 7) * 64 + 8 * hi;
#pragma unroll
            for (int ks = 0; ks < 4; ++ks) qf[rt][ks] = *(const GAS bf16x8*)(qp + 16 * ks);
#pragma unroll
            for (int i = 0; i < 16; ++i) wv[rt][i] = bf2f(proj[(rowbase + t0 + 4 * rt + (i >> 2)) * NPROJ + PC_WI + (i & 3) + 4 * hi]); }
        bf16x8 kf[4], kn[4];
        const bf16* kp0 = proj + (rowbase + r32) * NPROJ + PC_KI + 8 * hi;
        if (wid < ntile) {
#pragma unroll
            for (int ks = 0; ks < 4; ++ks) kf[ks] = *(const GAS bf16x8*)(kp0 + (size_t)(32 * wid) * NPROJ + 16 * ks); }
        for (int kt = wid; kt < ntile; kt += NWAVES) {
            const bool more = kt + NWAVES < ntile;
            if (more) {
#pragma unroll
                for (int ks = 0; ks < 4; ++ks) kn[ks] = *(const GAS bf16x8*)(kp0 + (size_t)(32 * (kt + NWAVES)) * NPROJ + 16 * ks); }
#pragma unroll
            for (int rt = 0; rt < 2; ++rt) { f32x16 acc = (f32x16){};
#pragma unroll
                for (int ks = 0; ks < 4; ++ks) acc = __builtin_amdgcn_mfma_f32_32x32x16_bf16(qf[rt][ks], kf[ks], acc, 0, 0, 0);
                float s[4];
#pragma unroll
                for (int tq = 0; tq < 4; ++tq) { float a = 0.f;
#pragma unroll
                    for (int j = 0; j < 4; ++j) a = fmaf(wv[rt][4 * tq + j], fmaxf(acc[4 * tq + j], 0.f), a);
                    s[tq] = a; }
#pragma unroll
                for (int pp = 0; pp < 2; ++pp) { auto rr = __builtin_amdgcn_permlane32_swap(__float_as_uint(s[2 * pp]), __float_as_uint(s[2 * pp + 1]), false, false);
                    const float v = (__uint_as_float(rr[0]) + __uint_as_float(rr[1])) + 0.0f;
                    const int q = 4 * rt + 2 * pp + hi, key = 32 * kt + r32;
                    unsigned u = __float_as_uint(v); u ^= ((unsigned)((int)u >> 31) | 0x80000000u);
                    sc[q * SEQ + key] = (key <= t0 + q) ? u : 0u; }
            }
            if (more) {
#pragma unroll
                for (int ks = 0; ks < 4; ++ks) kf[ks] = kn[ks]; }
        }
    }
    __syncthreads();
    _Pragma("unroll 1") for (int rep_q = 0; rep_q < IDX_REP_SEL; ++rep_q)
    {
        const int t = t0 + wid, n = t + 1;
        unsigned long long myword = 0ull;
        if (n <= 256) {
#pragma unroll
            for (int r = 0; r < 4; ++r) { const unsigned long long mm = __ballot(64 * r + lane <= t); if (lane == r) myword = mm; }
        } else {
            const int nreg = (n + 63) >> 6;
            unsigned x[64];
#pragma unroll
            for (int g = 0; g < 8; ++g) {
                if (8 * g < nreg) {
#pragma unroll
                    for (int j = 0; j < 8; ++j) { const int r = 8 * g + j; const unsigned u = sc[wid * SEQ + 64 * r + lane]; x[r] = (64 * r + lane <= t) ? u : 0u; }
                } else {
#pragma unroll
                    for (int j = 0; j < 8; ++j) x[8 * g + j] = 0u;
                }
            }
            unsigned lo = 1u, hi_k = 0xFFFFFFFFu; int clo = n, chi = 0; bool has_lo = false, has_hi = false;
            unsigned probe = prev_tau, step = 1u << 19;
#pragma unroll 1
            for (int it = 0; it < 96; ++it) {
                if (clo - chi <= 64 || hi_k - lo <= 1u) break;
                unsigned gg = (has_lo && has_hi) ? lo + ((hi_k - lo) >> 1) : probe;
                if (gg <= lo || gg >= hi_k) gg = lo + ((hi_k - lo) >> 1);
                int cnt; IDX_COUNT_GE(gg, cnt);
                if (cnt >= 256) { lo = gg; clo = cnt; has_lo = true; probe = gg + step; if (probe < gg) probe = 0xFFFFFFFEu; }
                else { hi_k = gg; chi = cnt; has_hi = true; probe = gg - step; if (probe > gg) probe = 2u; }
                step <<= 1; if (step == 0u) step = 1u << 31;
            }
            unsigned v; int cgt;
            if (hi_k - lo <= 1u) { v = lo; cgt = chi; }
            else {
                const int mcand = clo - chi, need = 256 - chi; int base = 0;
#pragma unroll
                for (int g = 0; g < 8; ++g) if (8 * g < nreg) {
#pragma unroll
                    for (int j = 0; j < 8; ++j) { const int r = 8 * g + j; const bool mt = (x[r] >= lo) && (x[r] < hi_k);
                        const unsigned long long bm = __ballot(mt);
                        const int pos = base + (int)__builtin_amdgcn_mbcnt_hi((unsigned)(bm >> 32), __builtin_amdgcn_mbcnt_lo((unsigned)bm, 0u));
                        if (mt) candl[pos & 63] = x[r];
                        base += __builtin_popcountll(bm);
                        asm volatile("" : "+s"(base) :: "memory"); }
                }
                const unsigned my = (lane < mcand) ? candl[lane] : 0u;
                int cge = 0;
#pragma unroll 1
                for (int j = 0; j < mcand; ++j) { const unsigned cj = (unsigned)__builtin_amdgcn_readlane((int)my, j); cge += (cj >= my) ? 1 : 0; }
                const bool okc = (lane < mcand) && (cge >= need);
                unsigned vm = okc ? my : 0u;
                { unsigned long long okm = __ballot(okc); unsigned best = 0u;
                  while (okm) { const int j = __builtin_ctzll(okm); okm &= okm - 1; const unsigned cj = (unsigned)__builtin_amdgcn_readlane((int)vm, j); best = cj > best ? cj : best; }
                  v = best; }
                cgt = chi + __builtin_popcountll(__ballot((lane < mcand) && (my > v)));
            }
            prev_tau = v;
            const int ntake = 256 - cgt; int taken = 0;
#pragma unroll
            for (int g = 0; g < 8; ++g) if (8 * g < nreg) {
#pragma unroll
                for (int j = 0; j < 8; ++j) { const int r = 8 * g + j; const bool eq = (x[r] == v), gt = (x[r] > v);
                    const unsigned long long eqm = __ballot(eq);
                    const int rank = taken + (int)__builtin_amdgcn_mbcnt_hi((unsigned)(eqm >> 32), __builtin_amdgcn_mbcnt_lo((unsigned)eqm, 0u));
                    const unsigned long long mm = __ballot(gt || (eq && rank < ntake));
                    if (lane == r) myword = mm;
                    taken += __builtin_popcountll(eqm);
                    asm volatile("" : "+v"(myword), "+s"(taken)); }
            }
        }
        maskw[((size_t)b * 64 + lane) * SEQ + t] = myword;
    }
    __syncthreads();
}

#ifndef MK_SPLIT
#define MK_SPLIT 0
#endif
constexpr int N_PHASES = 25;
__global__ void __launch_bounds__(NWAVES * 64, 2) fwd_kernel(Ptrs Pin) {
    typedef const __attribute__((address_space(4))) Ptrs* KargPtr;
    extern __shared__ __attribute__((aligned(16))) unsigned char lds_raw[];
    Frame F;
    F.lds = (LAS unsigned char*)lds_raw;
    volatile LAS unsigned* MISC = (volatile LAS unsigned*)(F.lds + MISC_OFF);
    F.tid = threadIdx.x; F.lane = F.tid & 63; F.wave = __builtin_amdgcn_readfirstlane(F.tid >> 6);
    F.bid = blockIdx.x; F.G = gridDim.x; { const int bx = blockIdx.x; F.vcu = (F.G % 8 == 0) ? (bx % 8) * (F.G / 8) + bx / 8 : bx; }
    for (int u = F.tid; u < (LDS_BYTES - LDSCTL_OFF) / 4; u += NWAVES * 64) ((LAS unsigned*)(F.lds + LDSCTL_OFF))[u] = 0u;
    __syncthreads();
    unsigned* ctl = (unsigned*)(Pin.ws + WS_CTL);
    if (!MK_SPLIT) (void)xcd_barrier_post(ctl + CW_BAR, MISC + 8);
    const int lo = Pin.ph_lo, hi = Pin.ph_hi; (void)lo; (void)hi;
    int ph = 0;
#if MK_SPLIT
#define PH_COND (lo <= ph && ph < hi)
#else
#define PH_COND true
#endif
#define PH_BEGIN if (PH_COND) { asm volatile("" : "+s"(F.wave), "+s"(F.vcu), "+s"(F.G), "+s"(F.bid)); F.lane = (int)__builtin_amdgcn_mbcnt_hi(~0u, __builtin_amdgcn_mbcnt_lo(~0u, 0u)); asm volatile("" : "+v"(F.lane)); F.tid = F.wave * 64 + F.lane; KargPtr pk_ = (KargPtr)__builtin_amdgcn_kernarg_segment_ptr(); asm volatile("" : "+s"(pk_));
#define PH_END   if (!MK_SPLIT && ph + 1 < N_PHASES) { unsigned char* wsx_ = P.ws; XcdBarrier b2_; b2_.bar = (unsigned*)(wsx_ + WS_CTL) + CW_BAR; b2_.x = xb_xcc_id(); b2_.st = MISC + 8; b2_.t0 = (F.tid == 0); xcd_barrier(b2_); } } ++ph;

#define P (*pk_)
#define H ((bf16*)(P.ws + WS_H))
#define PROJ ((bf16*)(P.ws + WS_PROJ))
#define ACT ((bf16*)(P.ws + WS_PROJ))
#define OB ((bf16*)(P.ws + WS_O))
#define MASKW ((unsigned long long*)(P.ws + WS_MASK))
#define wl (P.ws + WS_W + (size_t)l * LAYER_W_BYTES)
#define modl ((const float*)(P.ws + WS_MOD) + (size_t)l * NB * NMODC)
#define xin ((l == 0) ? P.x : P.out)

    PH_BEGIN p0_prologue(F, pk_); PH_END

#pragma unroll 1
    for (int l = 0; l < 2; ++l) {
        PH_BEGIN norm_mod_phase<true>(F, xin, P.norm_ffn1 + l * DM, modl, 0, 1, H); PH_END
        PH_BEGIN { pg8::Gemm g{H, (const bf16*)(wl + OFF_WGU1), MTOK, NGU, DM / 2}; pg8::StaticOrder S; S.init(MTOK, NGU, F.G, F.bid);
                   pg8::EpiSwiGLU<true> E{ACT, DFF}; pg8::gemm_phase<pg8::EpiSwiGLU<true>, pg8::StaticOrder, true, true, true>(F.lds, g, S, E, F.wave); } PH_END
        PH_BEGIN { pg8::Gemm g{ACT, (const bf16*)(wl + OFF_WD1), MTOK, DM, DFF / 2}; pg8::StaticOrder S; S.init(MTOK, DM, F.G, F.bid);
                   pg8::EpiResid E{xin, P.out, modl, 2, 0.5f}; pg8::gemm_phase<pg8::EpiResid, pg8::StaticOrder, true, true, true>(F.lds, g, S, E, F.wave); } PH_END
        PH_BEGIN norm_mod_phase<false>(F, P.out, P.norm_mix + l * DM, modl, 3, 4, H); PH_END
        PH_BEGIN { pg8::Gemm g{H, (const bf16*)(wl + OFF_WIN), MTOK, NPROJ, DM}; pg8::StaticOrder S; S.init(MTOK, NPROJ, F.G, F.bid);
                   pg8::EpiProj E{PROJ, NPROJ, P.qn_a + l * 64, P.kn_a + l * 64, P.qn_c + l * 64, P.kn_c + l * 64, QSCALE};
                   pg8::gemm_phase<pg8::EpiProj, pg8::StaticOrder, true, true>(F.lds, g, S, E, F.wave); } PH_END
        PH_BEGIN { unsigned prev_tau = 0xC1800000u;
                   for (int u = F.bid; u < NB * 512; u += F.G) { const int b = u >> 9, r = u & 511, qg = r < 256 ? r : 767 - r; idx_unit(F, b, qg, PROJ, MASKW, prev_tau); } } PH_END
        PH_BEGIN {
            for (int p = F.vcu; p < 256; p += F.G) { const int bh = p >> 3, b = bh >> 2, h = bh & 3, s = p & 7; const float slope2 = exp2f(-(float)(2 * h + 2)) * LOG2E;
                att::attA_unit(b, h, s, PROJ, MASKW, OB, F.lds, slope2, F.wave); att::attA_unit(b, h, 15 - s, PROJ, MASKW, OB, F.lds, slope2, F.wave); }
            for (int u = F.vcu; u < 512; u += F.G) { const int bh = u >> 4; att::attB_unit(bh >> 2, bh & 3, u & 15, PROJ, OB, F.lds, F.wave); }
            __syncthreads();
            for (int u = F.vcu; u < 512; u += F.G) { const int bh = u >> 3, h = bh & 7; const int idx = 3 * (h >> 1) + (h & 1);
                att::attC_unit(bh >> 3, h, u & 7, PROJ, OB, F.lds, exp2f(-(2.0f / 3.0f) * (float)(idx + 1)) * LOG2E, F.wave); }
        } PH_END
        PH_BEGIN group_norm_phase(F, OB, H); PH_END
        PH_BEGIN { pg8::Gemm g{H, (const bf16*)(wl + OFF_WOUT), MTOK, DM, DM}; pg8::StaticOrder S; S.init(MTOK, DM, F.G, F.bid);
                   pg8::EpiResid E{P.out, P.out, modl, 5, 1.0f}; pg8::gemm_phase<pg8::EpiResid, pg8::StaticOrder, true, true>(F.lds, g, S, E, F.wave); } PH_END
        PH_BEGIN norm_mod_phase<true>(F, P.out, P.norm_ffn2 + l * DM, modl, 6, 7, H); PH_END
        PH_BEGIN { pg8::Gemm g{H, (const bf16*)(wl + OFF_WGU2), MTOK, NGU, DM / 2}; pg8::StaticOrder S; S.init(MTOK, NGU, F.G, F.bid);
                   pg8::EpiSwiGLU<true> E{ACT, DFF}; pg8::gemm_phase<pg8::EpiSwiGLU<true>, pg8::StaticOrder, true, true, true>(F.lds, g, S, E, F.wave); } PH_END
        PH_BEGIN { pg8::Gemm g{ACT, (const bf16*)(wl + OFF_WD2), MTOK, DM, DFF / 2}; pg8::StaticOrder S; S.init(MTOK, DM, F.G, F.bid);
                   pg8::EpiResid E{P.out, P.out, modl, 8, 0.5f}; pg8::gemm_phase<pg8::EpiResid, pg8::StaticOrder, true, true, true>(F.lds, g, S, E, F.wave); } PH_END
    }
#undef PH_BEGIN
#undef PH_END
#undef P
#undef H
#undef PROJ
#undef ACT
#undef OB
#undef MASKW
#undef wl
#undef modl
#undef xin
}

extern "C" void kernel_launch(void* const* d_in, const int* in_sizes, int n_in, void* d_out, int out_size, void* d_ws, size_t ws_size, hipStream_t stream) {
    static int grid = 0;
    if (grid == 0) {
        if (n_in != 20 || in_sizes[0] != MTOK * DM || out_size != MTOK * DM || ws_size < WS_END) { fprintf(stderr, "kernel_launch: unexpected shapes (n_in %d, in0 %d, out %d, ws %zu); nothing launched\n", n_in, n_in > 0 ? in_sizes[0] : -1, out_size, ws_size); grid = -1; return; }
        int dev = 0, cus = 0, per_cu = 0;
        if (hipGetDevice(&dev) != hipSuccess || hipDeviceGetAttribute(&cus, hipDeviceAttributeMultiprocessorCount, dev) != hipSuccess) { grid = -1; return; }
        if (hipFuncSetAttribute((const void*)fwd_kernel, hipFuncAttributeMaxDynamicSharedMemorySize, LDS_BYTES) != hipSuccess) { fprintf(stderr, "kernel_launch: hipFuncSetAttribute failed\n"); grid = -1; return; }
        if (hipOccupancyMaxActiveBlocksPerMultiprocessor(&per_cu, (const void*)fwd_kernel, NWAVES * 64, LDS_BYTES) != hipSuccess || per_cu < 1)
            fprintf(stderr, "kernel_launch: note: occupancy query reports %d workgroups per CU\n", per_cu);
        (void)hipGetLastError();
        grid = cus;
    }
    if (grid < 0) return;
    if (hipMemsetAsync((char*)d_ws + WS_CTL, 0, CTL_ZERO_BYTES, stream) != hipSuccess) return;
    Ptrs a{};
    const float** pp = (const float**)&a;
    for (int i = 0; i < 20; ++i) pp[i] = (const float*)d_in[i];
    a.out = (float*)d_out; a.ws = (unsigned char*)d_ws;
#if MK_SPLIT
    for (int k = 0; k < N_PHASES; ++k) { a.ph_lo = k; a.ph_hi = k + 1; hipLaunchKernelGGL(fwd_kernel, dim3(grid), dim3(NWAVES * 64), LDS_BYTES, stream, a); }
#else
    a.ph_lo = 0; a.ph_hi = N_PHASES;
    hipLaunchKernelGGL(fwd_kernel, dim3(grid), dim3(NWAVES * 64), LDS_BYTES, stream, a);
#endif
    const hipError_t le = hipPeekAtLastError();
    if (le != hipSuccess) fprintf(stderr, "kernel_launch: launch failed: %s\n", hipGetErrorName(le));
}
```

```cpp
#include <hip/hip_runtime.h>
#include <cstdio>
#include <cstdint>
namespace pg8 {
#define PG8_LAS __attribute__((address_space(3)))
typedef unsigned short bf16_t;
typedef short bf16x8 __attribute__((ext_vector_type(8)));
typedef float f32x4 __attribute__((ext_vector_type(4)));
typedef unsigned u32x4 __attribute__((ext_vector_type(4)));
constexpr int BM = 256, BK = 64, HALF = 128, HTB = HALF * BK * 2  , STAGE_BYTES = 8 * HTB, NXCD = 8, WGM = 8;

__host__ __device__ __forceinline__ int lds_byte(int r, int c) { const int st = (r >> 4) * 2 + (c >> 5), rr = r & 15, cc = c & 31, ob = rr * 64 + cc * 2; return st * 1024 + (ob ^ (((ob >> 9) & 1) << 5)); }
__host__ __device__ __forceinline__ void stage_rc(int b, int& R, int& C) { const int st = b / 1024, sb = b % 1024, swz = sb ^ (((sb >> 9) & 1) << 5); R = (st >> 1) * 16 + swz / 64; C = (st & 1) * 32 + (swz % 64) / 2; }
__host__ __device__ __forceinline__ int perm32(int rho) { const int n = rho >> 4, i = rho & 15; return 8 * (i >> 2) + 4 * n + (i & 3); }

struct Unit { int pm, pn; };
struct Gemm { const bf16_t* A; const bf16_t* Bt; int M, N, K; };

struct StaticOrder {
    int nM, nN, nwg, G, c;
    __host__ __device__ void init(int M, int N, int G_, int c_) { nM = M / BM; nN = N / BM; nwg = nM * nN; G = G_; c = c_; }
    __host__ __device__ bool next(int i, Unit& u) const {
        const long L = (long)i * G + c; if (L >= nwg) return false;
        int wgid = (int)L; { const int q = nwg / NXCD, r = nwg % NXCD, xcd = wgid % NXCD, off = wgid / NXCD; wgid = (xcd < r ? xcd * (q + 1) : r * (q + 1) + (xcd - r) * q) + off; }
        const int nig = WGM * nN, gid = wgid / nig, fm = gid * WGM, gsz = (nM - fm) < WGM ? (nM - fm) : WGM;
        u.pm = fm + ((wgid % nig) % gsz); u.pn = (wgid % nig) / gsz; return true;
    }
    __device__ __forceinline__ void a_ready(const Unit&) const {}
    __device__ __forceinline__ void done(const Unit&) const {}
};

typedef float f32x2 __attribute__((ext_vector_type(2)));
typedef __bf16 bf16x2_t __attribute__((ext_vector_type(2)));
__device__ __forceinline__ unsigned cvt_pk_bf16(float lo, float hi) { f32x2 v = {lo, hi}; bf16x2_t b = __builtin_convertvector(v, bf16x2_t); return __builtin_bit_cast(unsigned, b); }

__device__ __forceinline__ float xsum16(float v) { auto t = __builtin_amdgcn_permlane16_swap(__float_as_uint(v), __float_as_uint(v), false, false); return __uint_as_float(t[0]) + __uint_as_float(t[1]); }
__device__ __forceinline__ float xsum32(float v) { auto t = __builtin_amdgcn_permlane32_swap(__float_as_uint(v), __float_as_uint(v), false, false); return __uint_as_float(t[0]) + __uint_as_float(t[1]); }
#define PG8_DPP_ADD(v, ctrl) ((v) + __uint_as_float((unsigned)__builtin_amdgcn_update_dpp(0, (int)__float_as_uint(v), ctrl, 0xF, 0xF, true)))
__device__ __forceinline__ float wave_sum_f(float v) {
    v = PG8_DPP_ADD(v, 0xB1); v = PG8_DPP_ADD(v, 0x4E); v = PG8_DPP_ADD(v, 0x141); v = PG8_DPP_ADD(v, 0x140);
    return xsum32(xsum16(v));
}
__device__ __forceinline__ unsigned pk4_fp8(float a, float b, float c, float d) {
    a = __builtin_amdgcn_fmed3f(a, -448.f, 448.f); b = __builtin_amdgcn_fmed3f(b, -448.f, 448.f); c = __builtin_amdgcn_fmed3f(c, -448.f, 448.f); d = __builtin_amdgcn_fmed3f(d, -448.f, 448.f);
    int w = __builtin_amdgcn_cvt_pk_fp8_f32(a, b, 0, false); w = __builtin_amdgcn_cvt_pk_fp8_f32(c, d, w, true); return (unsigned)w; }
template <bool F8OUT> struct EpiSwiGLU {
    static constexpr bool PERM = true, AFTER_DRAIN = false;
    bf16_t* O; int ldc;
    __device__ __forceinline__ void operator()(const f32x4 (&acc)[2][2][4][2], const Unit& u, int wr, int wc, int fr, int fq) const {
        const int row0 = u.pm * BM + wr * 64 + fr, col0 = u.pn * HALF + wc * 32 + 8 * fq;
#pragma unroll
        for (int ai = 0; ai < 2; ++ai)
#pragma unroll
            for (int m = 0; m < 4; ++m) {
                float v[8];
#pragma unroll
                for (int n = 0; n < 2; ++n)
#pragma unroll
                    for (int j = 0; j < 4; ++j) { const float g = acc[ai][0][m][n][j], up = acc[ai][1][m][n][j];
                        const float e = __builtin_amdgcn_exp2f(g * -1.4426950408889634f);
                        v[n * 4 + j] = g * __builtin_amdgcn_rcpf(1.0f + e) * up; }
                if constexpr (F8OUT) { typedef unsigned u32x2_ __attribute__((ext_vector_type(2))); unsigned char* rowp = (unsigned char*)O + (size_t)(row0 + ai * HALF + m * 16) * ldc + col0;
                    u32x2_ w; w.x = pk4_fp8(v[0], v[1], v[2], v[3]); w.y = pk4_fp8(v[4], v[5], v[6], v[7]); *(u32x2_*)rowp = w; }
                else { bf16_t* rowp = O + (size_t)(row0 + ai * HALF + m * 16) * ldc + col0;
                    u32x4 w; w.x = cvt_pk_bf16(v[0], v[1]); w.y = cvt_pk_bf16(v[2], v[3]); w.z = cvt_pk_bf16(v[4], v[5]); w.w = cvt_pk_bf16(v[6], v[7]);
                    *(u32x4*)rowp = w; }
            }
    }
};

template <bool BASE_BF16, bool OUT_BF16> struct EpiResid {
    static constexpr bool PERM = true, AFTER_DRAIN = false;
    const void* base; void* out; const float* modl; int chunk; float coef;
    __device__ __forceinline__ void operator()(const f32x4 (&acc)[2][2][4][2], const Unit& u, int wr, int wc, int fr, int fq) const {
        const int row0 = u.pm * BM + wr * 64 + fr, col0 = u.pn * BM + wc * 32 + 8 * fq;
        const float* gate = modl + (size_t)(u.pm >> 4) * 9216 + chunk * 1024;
        f32x4 gv[2][2];
#pragma unroll
        for (int bj = 0; bj < 2; ++bj)
#pragma unroll
            for (int n = 0; n < 2; ++n) gv[bj][n] = *(const f32x4*)(gate + col0 + bj * HALF + 4 * n) * coef;
        if constexpr (BASE_BF16) {
#pragma unroll
            for (int ai = 0; ai < 2; ++ai) { u32x4 wb[4][2];
#pragma unroll
                for (int m = 0; m < 4; ++m)
#pragma unroll
                    for (int bj = 0; bj < 2; ++bj) wb[m][bj] = *(const u32x4*)((const bf16_t*)base + (size_t)(row0 + ai * HALF + m * 16) * 1024 + col0 + bj * HALF);
                asm volatile("" ::: "memory");
#pragma unroll
                for (int m = 0; m < 4; ++m)
#pragma unroll
                    for (int bj = 0; bj < 2; ++bj) { const size_t o = (size_t)(row0 + ai * HALF + m * 16) * 1024 + col0 + bj * HALF; const u32x4 w = wb[m][bj];
                        const f32x4 b0 = (f32x4){__uint_as_float(w.x << 16), __uint_as_float(w.x & 0xffff0000u), __uint_as_float(w.y << 16), __uint_as_float(w.y & 0xffff0000u)};
                        const f32x4 b1 = (f32x4){__uint_as_float(w.z << 16), __uint_as_float(w.z & 0xffff0000u), __uint_as_float(w.w << 16), __uint_as_float(w.w & 0xffff0000u)};
                        const f32x4 r0 = b0 + gv[bj][0] * acc[ai][bj][m][0], r1 = b1 + gv[bj][1] * acc[ai][bj][m][1];
                        if constexpr (OUT_BF16) { u32x4 wo; wo.x = cvt_pk_bf16(r0[0], r0[1]); wo.y = cvt_pk_bf16(r0[2], r0[3]); wo.z = cvt_pk_bf16(r1[0], r1[1]); wo.w = cvt_pk_bf16(r1[2], r1[3]); *(u32x4*)((bf16_t*)out + o) = wo; }
                        else { *(f32x4*)((float*)out + o) = r0; *(f32x4*)((float*)out + o + 4) = r1; } }
                asm volatile("" ::: "memory"); }
            return; }
#pragma unroll
        for (int ai = 0; ai < 2; ++ai)
#pragma unroll
            for (int m = 0; m < 4; ++m) { const size_t off = (size_t)(row0 + ai * HALF + m * 16) * 1024 + col0;
#pragma unroll
                for (int bj = 0; bj < 2; ++bj) { const size_t o = off + bj * HALF; f32x4 b0, b1;
                    if constexpr (BASE_BF16) { const u32x4 w = *(const u32x4*)((const bf16_t*)base + o);
                        b0 = (f32x4){__uint_as_float(w.x << 16), __uint_as_float(w.x & 0xffff0000u), __uint_as_float(w.y << 16), __uint_as_float(w.y & 0xffff0000u)};
                        b1 = (f32x4){__uint_as_float(w.z << 16), __uint_as_float(w.z & 0xffff0000u), __uint_as_float(w.w << 16), __uint_as_float(w.w & 0xffff0000u)}; }
                    else { b0 = *(const f32x4*)((const float*)base + o); b1 = *(const f32x4*)((const float*)base + o + 4); }
                    const f32x4 r0 = b0 + gv[bj][0] * acc[ai][bj][m][0], r1 = b1 + gv[bj][1] * acc[ai][bj][m][1];
                    if constexpr (OUT_BF16) { u32x4 w; w.x = cvt_pk_bf16(r0[0], r0[1]); w.y = cvt_pk_bf16(r0[2], r0[3]); w.z = cvt_pk_bf16(r1[0], r1[1]); w.w = cvt_pk_bf16(r1[2], r1[3]); *(u32x4*)((bf16_t*)out + o) = w; }
                    else { *(f32x4*)((float*)out + o) = r0; *(f32x4*)((float*)out + o + 4) = r1; } }
                if (m & 1) asm volatile("" ::: "memory"); }
    }
};

struct EpiProj {
    static constexpr bool PERM = true, AFTER_DRAIN = false;
    static constexpr size_t HB = 4096 * 128;
    bf16_t* QB; unsigned char* KV; float* WI; const float *qn_a, *kn_a, *qn_c, *kn_c; float qscale;
    static constexpr size_t KT_A = 0, KT_B = 32 * HB, KT_C = 64 * HB, KT_I = 256 * HB, VT_A = 264 * HB, VT_B = 296 * HB, VT_C = 328 * HB, KV_BYTES = 392 * HB, DSTRIDE = 64 * HB;
    __device__ __forceinline__ void operator()(const f32x4 (&acc)[2][2][4][2], const Unit& u, int wr, int wc, int fr, int fq) const {
        const int pn = u.pn;
        if (pn == 14 && wc >= 2) return;
        const float* gain = pn == 0 ? qn_a : pn == 1 ? kn_a : (pn == 6 || pn == 7) ? qn_c : (pn == 8 || pn == 9) ? kn_c : nullptr;
        const float sc = (pn == 0 || pn == 3 || pn == 6 || pn == 7) ? qscale : 1.0f;
        const int row0 = u.pm * BM + wr * 64 + fr, b = u.pm >> 4, t0 = (u.pm & 15) * BM + wr * 64 + fr;
        f32x4 gv[2][2];
#pragma unroll
        for (int bj = 0; bj < 2; ++bj)
#pragma unroll
            for (int n = 0; n < 2; ++n) gv[bj][n] = gain ? *(const f32x4*)(gain + 32 * bj + 8 * fq + 4 * n) * sc : (f32x4){sc, sc, sc, sc};
        int kind, nd = 1; size_t base = 0; int qcol = 0;
        if (pn == 0) { kind = 0; qcol = 0; } else if (pn == 3) { kind = 0; qcol = 256; } else if (pn == 6 || pn == 7) { kind = 0; qcol = 512 + 256 * (pn - 6); } else if (pn == 12 || pn == 13) { kind = 0; qcol = 1024 + 256 * (pn - 12); }
        else if (pn == 1) { kind = 1; base = KT_A + (size_t)(b * 4 + wc) * HB; } else if (pn == 4) { kind = 1; base = KT_B + (size_t)(b * 4 + wc) * HB; }
        else if (pn == 8 || pn == 9) { kind = 1; nd = 3; base = KT_C + (size_t)(b * 8 + 4 * (pn - 8) + wc) * HB; }
        else if (pn == 2) { kind = 2; base = VT_A + (size_t)(b * 4 + wc) * HB; } else if (pn == 5) { kind = 2; base = VT_B + (size_t)(b * 4 + wc) * HB; }
        else if (pn == 10 || pn == 11) { kind = 2; base = VT_C + (size_t)(b * 8 + 4 * (pn - 10) + wc) * HB; }
        else { if (wc == 0) { kind = 1; base = KT_I + (size_t)b * HB; } else kind = 3; }
#pragma unroll
        for (int ai = 0; ai < 2; ++ai)
#pragma unroll
            for (int m = 0; m < 4; ++m) {
                float rs = 1.0f;
                if (gain) { float ss = 0.f;
#pragma unroll
                    for (int bj = 0; bj < 2; ++bj)
#pragma unroll
                        for (int n = 0; n < 2; ++n) { const f32x4 x = acc[ai][bj][m][n]; ss += (x[0] * x[0] + x[1] * x[1]) + (x[2] * x[2] + x[3] * x[3]); }
                    ss = xsum32(xsum16(ss));
                    rs = __builtin_amdgcn_rsqf(ss * (1.0f / 64.0f) + 1e-6f); }
                const int t = t0 + ai * HALF + m * 16;
                if (kind == 3) { if (fq == 0) { float* wp = WI + (size_t)(row0 + ai * HALF + m * 16) * 8; *(f32x4*)wp = acc[ai][0][m][0]; *(f32x4*)(wp + 4) = acc[ai][0][m][1]; } continue; }
#pragma unroll
                for (int bj = 0; bj < 2; ++bj) { const f32x4 v0 = acc[ai][bj][m][0] * gv[bj][0] * rs, v1 = acc[ai][bj][m][1] * gv[bj][1] * rs;
                    u32x4 w; w.x = cvt_pk_bf16(v0[0], v0[1]); w.y = cvt_pk_bf16(v0[2], v0[3]); w.z = cvt_pk_bf16(v1[0], v1[1]); w.w = cvt_pk_bf16(v1[2], v1[3]);
                    if (kind == 0) *(u32x4*)(QB + (size_t)(row0 + ai * HALF + m * 16) * 1536 + qcol + wc * 64 + 32 * bj + 8 * fq) = w;
                    else {
                        for (int d = 0; d < nd; ++d) { const int sh = 2 * d, p = ((t & ((1 << sh) - 1)) << (12 - sh)) + (t >> sh);
                            unsigned char* dst = KV + base + (size_t)d * DSTRIDE;
                            if (kind == 1) dst += (size_t)(((p >> 5) * 8 + 4 * bj + fq) * 512 + (p & 31) * 16);
                            else dst += (size_t)(((p >> 4) * 2 + bj) * 1024 + (p & 15) * 64 + fq * 16);
                            *(u32x4*)dst = w; } }
                }
            }
    }
};

template <class Epi, class Sched, bool ALIGN_EPI = false, bool SP2 = false, bool FP8 = false>
__device__ __forceinline__ void gemm_phase(PG8_LAS unsigned char* lds, const Gemm g, const Sched& S, const Epi& E, int wave_id) {
    int tid_o = wave_id * 64 + (int)__builtin_amdgcn_mbcnt_hi(~0u, __builtin_amdgcn_mbcnt_lo(~0u, 0u)); asm volatile("" : "+v"(tid_o));
    const int tid = tid_o, wid = __builtin_amdgcn_readfirstlane(tid >> 6), lane = tid & 63, wr = wid >> 2, wc = wid & 3, fr = lane & 15, fq = lane >> 4;
    const int K = g.K, nt = K / BK;
    unsigned voffA[2], voffB[2];
#pragma unroll
    for (int i = 0; i < 2; ++i) { int R, C; stage_rc(tid * 16 + i * 8192, R, C); const int Rb = Epi::PERM ? ((R & ~31) + perm32(R & 31)) : R;
        voffA[i] = (unsigned)(R * K + C) * 2u; voffB[i] = (unsigned)(Rb * K + C) * 2u; }
    const size_t kstep = (size_t)(BK * 2);
    const size_t hstep = (size_t)HALF * K * 2;
    const size_t tstep = 2 * hstep;
    const unsigned ldsw = (unsigned)wid * 1024u;
    const int aoff = lds_byte(wr * 64 + fr, fq * 8), boff = lds_byte(wc * 32 + fr, fq * 8);
#define PG8_SA(b, h) (((b) * 2 + (h)) * HTB)
#define PG8_SB(b, h) ((4 + (b) * 2 + (h)) * HTB)
#define PG8_STAGE(bufoff, gbase, voff) do { _Pragma("unroll") for (int _i = 0; _i < 2; ++_i) \
        __builtin_amdgcn_global_load_lds((const unsigned*)((const char*)(gbase) + (voff)[_i]), (PG8_LAS unsigned*)(lds + (bufoff) + ldsw + _i * 8192), 16, 0, 0); } while (0)
#define PG8_LDA(dst, b, h) do { _Pragma("unroll") for (int m = 0; m < 4; ++m) { \
        if constexpr (FP8) { dst##8[m].lo = *(const PG8_LAS i32x4_*)(lds + PG8_SA(b, h) + aoff + m * 2048); dst##8[m].hi = *(const PG8_LAS i32x4_*)(lds + PG8_SA(b, h) + aoff + m * 2048 + 1024); } \
        else { _Pragma("unroll") for (int k = 0; k < 2; ++k) dst[m][k] = *(const PG8_LAS bf16x8*)(lds + PG8_SA(b, h) + aoff + m * 2048 + k * 1024); } } } while (0)
#define PG8_LDB(dst, b, h) do { _Pragma("unroll") for (int n = 0; n < 2; ++n) { \
        if constexpr (FP8) { dst##8[n].lo = *(const PG8_LAS i32x4_*)(lds + PG8_SB(b, h) + boff + n * 2048); dst##8[n].hi = *(const PG8_LAS i32x4_*)(lds + PG8_SB(b, h) + boff + n * 2048 + 1024); } \
        else { _Pragma("unroll") for (int k = 0; k < 2; ++k) dst[n][k] = *(const PG8_LAS bf16x8*)(lds + PG8_SB(b, h) + boff + n * 2048 + k * 1024); } } } while (0)
#define PG8_MMA(ai, bj, At, Bt) do { __builtin_amdgcn_s_setprio(1); _Pragma("unroll") for (int m = 0; m < 4; ++m) _Pragma("unroll") for (int n = 0; n < 2; ++n) { \
          \
        if constexpr (FP8) asm volatile("v_mfma_scale_f32_16x16x128_f8f6f4 %0, %1, %2, %0, %3, %4 op_sel_hi:[0,0,0]" : "+v"(acc[ai][bj][m][n]) : "v"(Bt##8[n]), "v"(At##8[m]), "v"(scale_w_), "v"(scale_a_));   \
        else { _Pragma("unroll") for (int k = 0; k < 2; ++k) acc[ai][bj][m][n] = __builtin_amdgcn_mfma_f32_16x16x32_bf16(Bt[n][k], At[m][k], acc[ai][bj][m][n], 0, 0, 0); } } \
        __builtin_amdgcn_s_setprio(0); } while (0)
#define PG8_WAIT_V(n) asm volatile("s_waitcnt vmcnt(" #n ")" ::: "memory")
#define PG8_WAIT_L(n) asm volatile("s_waitcnt lgkmcnt(" #n ")" ::: "memory")
#define PG8_BAR __builtin_amdgcn_s_barrier()
#define PG8_SCHED __builtin_amdgcn_sched_barrier(0)
    Unit cur, nxt; int ui = 0;
    if (!S.next(0, cur)) return;
    f32x4 acc[2][2][4][2];
#pragma unroll
    for (int a = 0; a < 2; ++a)
#pragma unroll
        for (int b = 0; b < 2; ++b)
#pragma unroll
            for (int m = 0; m < 4; ++m)
#pragma unroll
                for (int n = 0; n < 2; ++n) acc[a][b][m][n] = (f32x4){0.f, 0.f, 0.f, 0.f};
    typedef int i32x8_ __attribute__((ext_vector_type(8))); typedef int i32x4_ __attribute__((ext_vector_type(4)));
    const int scale_w_ = 122, scale_a_ = 127;
    bf16x8 At[4][2], B0[2][2], B1[2][2]; i32x8_ At8[4], B08[2], B18[2];
    const char* cA = (const char*)g.A + (size_t)cur.pm * tstep; const char* cB = (const char*)g.Bt + (size_t)cur.pn * tstep;
    S.a_ready(cur);
    if constexpr (SP2) {
        PG8_STAGE(PG8_SB(0, 0), cB, voffB); PG8_STAGE(PG8_SB(0, 1), cB + hstep, voffB); PG8_STAGE(PG8_SA(0, 0), cA, voffA); PG8_STAGE(PG8_SA(0, 1), cA + hstep, voffA);
        if (wr == 1) PG8_BAR;
        PG8_WAIT_V(2); PG8_BAR;
        PG8_STAGE(PG8_SB(1, 0), cB + kstep, voffB); PG8_STAGE(PG8_SA(1, 0), cA + kstep, voffA); PG8_STAGE(PG8_SB(1, 1), cB + hstep + kstep, voffB);
        PG8_WAIT_V(6); PG8_BAR;
    } else {
        PG8_STAGE(PG8_SB(0, 0), cB, voffB); PG8_STAGE(PG8_SA(0, 0), cA, voffA); PG8_STAGE(PG8_SB(0, 1), cB + hstep, voffB); PG8_STAGE(PG8_SA(0, 1), cA + hstep, voffA);
        if (wr == 1) PG8_BAR;
        PG8_WAIT_V(4); PG8_BAR;
        PG8_STAGE(PG8_SB(1, 0), cB + kstep, voffB); PG8_STAGE(PG8_SA(1, 0), cA + kstep, voffA); PG8_STAGE(PG8_SB(1, 1), cB + hstep + kstep, voffB);
        PG8_WAIT_V(6); PG8_BAR;
    }
    for (;;) {
        const bool has_next = S.next(ui + 1, nxt);
        const char* nA = has_next ? (const char*)g.A + (size_t)nxt.pm * tstep : cA; const char* nB = has_next ? (const char*)g.Bt + (size_t)nxt.pn * tstep : cB;
        _Pragma("unroll 1") for (int t = 0; t < nt; t += 2) {
            const bool last = (t == nt - 2);
            const char* a1 = cA + (size_t)(t + 1) * kstep;
            const char* a2 = last ? nA : cA + (size_t)(t + 2) * kstep; const char* b2 = last ? nB : cB + (size_t)(t + 2) * kstep;
            const char* a3 = a2 + kstep; const char* b3 = b2 + kstep;
            if (last && has_next) S.a_ready(nxt);
            if constexpr (SP2) {
#ifndef PG8_STAGE_LATE
#define PG8_STAGE_LATE 1
#endif
#if PG8_STAGE_LATE
            PG8_LDB(B0, 0, 0); PG8_LDB(B1, 0, 1); PG8_SCHED; PG8_LDA(At, 0, 0);
            PG8_WAIT_V(6); PG8_WAIT_L(0); PG8_BAR; PG8_MMA(0, 0, At, B0); PG8_STAGE(PG8_SA(1, 1), a1 + hstep, voffA); PG8_MMA(0, 1, At, B1); PG8_BAR; PG8_SCHED;
            PG8_LDA(At, 0, 1);
            PG8_WAIT_V(2); PG8_WAIT_L(0); PG8_BAR; PG8_MMA(1, 0, At, B0); PG8_STAGE(PG8_SB(0, 0), b2, voffB); PG8_STAGE(PG8_SB(0, 1), b2 + hstep, voffB); PG8_STAGE(PG8_SA(0, 0), a2, voffA); PG8_MMA(1, 1, At, B1); PG8_BAR; PG8_SCHED;
            PG8_LDB(B0, 1, 0); PG8_LDB(B1, 1, 1); PG8_SCHED; PG8_LDA(At, 1, 0);
            PG8_WAIT_V(6); PG8_WAIT_L(0); PG8_BAR; PG8_MMA(0, 0, At, B0); PG8_STAGE(PG8_SA(0, 1), a2 + hstep, voffA); PG8_MMA(0, 1, At, B1); PG8_BAR; PG8_SCHED;
            PG8_LDA(At, 1, 1);
            PG8_WAIT_V(2); PG8_WAIT_L(0); PG8_BAR; PG8_MMA(1, 0, At, B0); PG8_STAGE(PG8_SB(1, 0), b3, voffB); PG8_STAGE(PG8_SB(1, 1), b3 + hstep, voffB); PG8_STAGE(PG8_SA(1, 0), a3, voffA); PG8_MMA(1, 1, At, B1); PG8_BAR; PG8_SCHED;
#else
            PG8_LDB(B0, 0, 0); PG8_LDB(B1, 0, 1); PG8_SCHED; PG8_LDA(At, 0, 0); PG8_STAGE(PG8_SA(1, 1), a1 + hstep, voffA);
            PG8_WAIT_V(8); PG8_WAIT_L(0); PG8_BAR; PG8_MMA(0, 0, At, B0); PG8_MMA(0, 1, At, B1); PG8_BAR; PG8_SCHED;
            PG8_LDA(At, 0, 1); PG8_STAGE(PG8_SB(0, 0), b2, voffB); PG8_STAGE(PG8_SB(0, 1), b2 + hstep, voffB); PG8_STAGE(PG8_SA(0, 0), a2, voffA);
            PG8_WAIT_V(8); PG8_WAIT_L(0); PG8_BAR; PG8_MMA(1, 0, At, B0); PG8_MMA(1, 1, At, B1); PG8_BAR; PG8_SCHED;
            PG8_LDB(B0, 1, 0); PG8_LDB(B1, 1, 1); PG8_SCHED; PG8_LDA(At, 1, 0); PG8_STAGE(PG8_SA(0, 1), a2 + hstep, voffA);
            PG8_WAIT_V(8); PG8_WAIT_L(0); PG8_BAR; PG8_MMA(0, 0, At, B0); PG8_MMA(0, 1, At, B1); PG8_BAR; PG8_SCHED;
            PG8_LDA(At, 1, 1); PG8_STAGE(PG8_SB(1, 0), b3, voffB); PG8_STAGE(PG8_SB(1, 1), b3 + hstep, voffB); PG8_STAGE(PG8_SA(1, 0), a3, voffA);
            PG8_WAIT_V(8); PG8_WAIT_L(0); PG8_BAR; PG8_MMA(1, 0, At, B0); PG8_MMA(1, 1, At, B1); PG8_BAR; PG8_SCHED;
#endif
            } else {
            PG8_LDB(B0, 0, 0); PG8_SCHED; PG8_LDA(At, 0, 0); PG8_STAGE(PG8_SA(1, 1), a1 + hstep, voffA);
            PG8_WAIT_L(8); PG8_BAR; PG8_WAIT_L(0); PG8_MMA(0, 0, At, B0); PG8_BAR; PG8_SCHED;
            PG8_LDB(B1, 0, 1); PG8_STAGE(PG8_SB(0, 0), b2, voffB);
            PG8_BAR; PG8_WAIT_L(0); PG8_MMA(0, 1, At, B1); PG8_BAR;
            PG8_LDA(At, 0, 1); PG8_STAGE(PG8_SA(0, 0), a2, voffA);
            PG8_BAR; PG8_WAIT_L(0); PG8_MMA(1, 0, At, B0); PG8_BAR; PG8_SCHED;
            PG8_STAGE(PG8_SB(0, 1), b2 + hstep, voffB);
            PG8_WAIT_V(6); PG8_BAR; PG8_MMA(1, 1, At, B1); PG8_BAR;
            PG8_LDB(B0, 1, 0); PG8_SCHED; PG8_LDA(At, 1, 0); PG8_STAGE(PG8_SA(0, 1), a2 + hstep, voffA);
            PG8_WAIT_L(8); PG8_BAR; PG8_WAIT_L(0); PG8_MMA(0, 0, At, B0); PG8_BAR; PG8_SCHED;
            PG8_LDB(B1, 1, 1); PG8_STAGE(PG8_SB(1, 0), b3, voffB);
            PG8_BAR; PG8_WAIT_L(0); PG8_MMA(0, 1, At, B1); PG8_BAR;
            PG8_LDA(At, 1, 1); PG8_STAGE(PG8_SA(1, 0), a3, voffA);
            PG8_BAR; PG8_WAIT_L(0); PG8_MMA(1, 0, At, B0); PG8_BAR; PG8_SCHED;
            PG8_STAGE(PG8_SB(1, 1), b3 + hstep, voffB);
            PG8_WAIT_V(6); PG8_BAR; PG8_MMA(1, 1, At, B1); PG8_BAR;
            }
        }
        if constexpr (FP8) asm volatile("s_nop 15\n\ts_nop 15" ::: "memory");
        if constexpr (ALIGN_EPI) { if (wr == 0) PG8_BAR; }
        if constexpr (!Epi::AFTER_DRAIN) { E(acc, cur, wr, wc, fr, fq); S.done(cur); }
        if (!has_next) break;
#pragma unroll
        for (int a = 0; a < 2; ++a)
#pragma unroll
            for (int b = 0; b < 2; ++b)
#pragma unroll
                for (int m = 0; m < 4; ++m)
#pragma unroll
                    for (int n = 0; n < 2; ++n) acc[a][b][m][n] = (f32x4){0.f, 0.f, 0.f, 0.f};
        cur = nxt; cA = nA; cB = nB; ++ui;
        if constexpr (ALIGN_EPI) { if (wr == 1) PG8_BAR; }
    }
    PG8_WAIT_V(0);
    if constexpr (!ALIGN_EPI) { if (wr == 0) PG8_BAR; }
    PG8_BAR;
    if constexpr (Epi::AFTER_DRAIN) { E.fused(acc, cur, wr, wc, fr, fq, lds, wid, lane); S.done(cur); }
#undef PG8_SA
#undef PG8_SB
#undef PG8_STAGE
#undef PG8_LDA
#undef PG8_LDB
#undef PG8_MMA
#undef PG8_WAIT_V
#undef PG8_WAIT_L
#undef PG8_BAR
#undef PG8_SCHED
}
}

constexpr int NB = 8, SEQ = 4096, DM = 1024, MTOK = NB * SEQ, DFF = 2816, NGU = 2 * DFF, NPROJ = 3840, NMODC = 9 * DM, WIN_COLS = 3656;
constexpr float LOG2E = 1.4426950408889634f, QSCALE = 0.125f * 1.4426950408889634f;
constexpr int NWAVES = 8;

constexpr size_t MiB = 1u << 20;
constexpr size_t WS_CTL = 0, CTL_ZERO_BYTES = 1 * MiB;
constexpr size_t WS_MOD = 2 * MiB;
constexpr size_t WS_W = 4 * MiB;
constexpr size_t OFF_WGU1 = 0, OFF_WD1 = OFF_WGU1 + (size_t)NGU * DM, OFF_WGU2 = OFF_WD1 + (size_t)DM * DFF, OFF_WD2 = OFF_WGU2 + (size_t)NGU * DM,
                 OFF_WIN = OFF_WD2 + (size_t)DM * DFF, OFF_WOUT = OFF_WIN + (size_t)NPROJ * DM * 2, LAYER_W_BYTES = OFF_WOUT + (size_t)DM * DM * 2;
constexpr size_t WS_WI = 3 * MiB;
constexpr size_t WS_H = 64 * MiB;
constexpr size_t WS_Q = 128 * MiB;
constexpr size_t WS_KV = 224 * MiB;
constexpr size_t WS_XB = 420 * MiB;
constexpr size_t WS_MASK = 484 * MiB;
constexpr size_t WS_END = 500 * MiB;
constexpr int QPITCH = 1536, QC_A = 0, QC_B = 256, QC_C = 512, QC_I = 1024;
static_assert(WS_W + 2 * LAYER_W_BYTES <= WS_H && WS_H + (size_t)MTOK * DM * 2 <= WS_Q && WS_Q + (size_t)MTOK * QPITCH * 2 <= WS_KV && WS_KV + pg8::EpiProj::KV_BYTES <= WS_XB && WS_XB + (size_t)MTOK * DM * 2 <= WS_MASK && WS_MASK + (size_t)NB * 64 * SEQ * 8 <= WS_END, "d_ws map");
constexpr int CW_BAR = 4096;
constexpr int RING_BYTES = 131072, EXTRA_OFF = RING_BYTES, LDSCTL_OFF = EXTRA_OFF + 4096, MISC_OFF = LDSCTL_OFF + 320, LDS_BYTES = 147456;

#define GAS __attribute__((address_space(1)))
#define LAS __attribute__((address_space(3)))
typedef unsigned short bf16;
typedef unsigned v4u __attribute__((ext_vector_type(4)));
typedef unsigned v2u __attribute__((ext_vector_type(2)));
typedef float f32x4 __attribute__((ext_vector_type(4)));
typedef short bf16x8 __attribute__((ext_vector_type(8)));
typedef GAS unsigned gu32;
#define LDS_WAIT() asm volatile("s_waitcnt lgkmcnt(0)" ::: "memory")
#define VM_WAIT() asm volatile("s_waitcnt vmcnt(0)" ::: "memory")
__device__ __forceinline__ unsigned pk2(float lo, float hi) { return pg8::cvt_pk_bf16(lo, hi); }
__device__ __forceinline__ float bf2f(bf16 v) { return __uint_as_float((unsigned)v << 16); }

#ifndef PROBE_T
#define PROBE_T 0
#endif
#ifndef PROBE_SHIFT
#define PROBE_SHIFT 0.0f
#endif
#ifndef PROBE_BLK
#define PROBE_BLK 128
#endif
#if PROBE_T
#define PT_START(k) do { if ((k) == PROBE_T) pt_t0 = __builtin_amdgcn_s_memtime(); } while (0)
#define PT_STOP(k)  do { if ((k) == PROBE_T) pt_acc += __builtin_amdgcn_s_memtime() - pt_t0; } while (0)
#else
#define PT_START(k) do {} while (0)
#define PT_STOP(k) do {} while (0)
#endif
#define XB_TMO      128
#define XB_XCNT(j)  (256  + 64 * (j))
#define XB_XSUB(j)  (1280 + 64 * (j))
#define XB_XGEN(j)  (2304 + 64 * (j))
#define XB_TOP      3328
#define XB_TOPGEN   3392
#define XCD_BAR_WORDS 3456
#define XB_SPIN_CAP (1u << 18)

__device__ __forceinline__ unsigned xb_ld(unsigned* p)              { return __hip_atomic_load(p, __ATOMIC_RELAXED, __HIP_MEMORY_SCOPE_AGENT); }
__device__ __forceinline__ unsigned xb_add(unsigned* p, unsigned v) { return __hip_atomic_fetch_add(p, v, __ATOMIC_RELAXED, __HIP_MEMORY_SCOPE_AGENT); }
__device__ __forceinline__ unsigned xb_xcc_id() { return (unsigned)__builtin_amdgcn_s_getreg((3 << 11) | 20) & 0xFu; }
#define XB_SPIN(cond, bar) do { unsigned _sp = 0; while (cond) { __builtin_amdgcn_s_sleep(1); \
    if ((++_sp & 255u) == 0u) { if (xb_ld(&(bar)[XB_TMO])) break; if (_sp > XB_SPIN_CAP) { atomicAdd(&(bar)[XB_TMO], 1u); break; } } } } while (0)

struct XcdBarrier {
    bool t0;
    unsigned* bar; unsigned x;
    volatile LAS unsigned* st;
};

__device__ __forceinline__ XcdBarrier xcd_barrier_post(unsigned* bar, volatile LAS unsigned* st) {
    XcdBarrier b; b.bar = bar; b.x = xb_xcc_id(); b.st = st; b.t0 = (threadIdx.x == 0);
    if (threadIdx.x == 0) (void)xb_add(&bar[XB_XCNT(b.x)], 1u);
    return b;
}
__device__ __forceinline__ void xcd_barrier_complete(unsigned* bar, unsigned x, unsigned& nloc, unsigned& nx) {
    const unsigned G = gridDim.x * gridDim.y * gridDim.z;
    unsigned sum, cnt, mine, sp = 0u;
    for (;;) {
        sum = 0u; cnt = 0u; mine = 0u;
#pragma unroll
        for (unsigned j = 0; j < 16; ++j) { const unsigned c = xb_ld(&bar[XB_XCNT(j)]); sum += c; cnt += (c > 0u) ? 1u : 0u; mine = (j == x) ? c : mine; }
        if (sum == G) break;
        __builtin_amdgcn_s_sleep(1);
        if ((++sp & 255u) == 0u) { if (xb_ld(&bar[XB_TMO])) break; if (sp > XB_SPIN_CAP) { atomicAdd(&bar[XB_TMO], 1u); break; } }
    }
    nloc = mine > 0u ? mine : 1u; nx = cnt > 0u ? cnt : 1u;
}

__device__ __forceinline__ void xcd_barrier(const XcdBarrier& b) {
    asm volatile("s_waitcnt vmcnt(0)" ::: "memory");
    __syncthreads();
    if (b.t0) {
        unsigned* bar = b.bar;
        __builtin_amdgcn_s_waitcnt(0);
        unsigned nloc = b.st[0], nx = b.st[1];
        if (nloc == 0u) { xcd_barrier_complete(bar, b.x, nloc, nx); b.st[0] = nloc; b.st[1] = nx; }
        const unsigned old = xb_add(&bar[XB_XSUB(b.x)], 1u);
        const unsigned gen = old / nloc;
        if (old + 1u == (gen + 1u) * nloc) {
            __builtin_amdgcn_fence(__ATOMIC_RELEASE, "agent");
            asm volatile("s_waitcnt vmcnt(0)" ::: "memory");
            const unsigned og = xb_add(&bar[XB_TOP], 1u);
            const unsigned tg = og / nx;
            if (og + 1u == (tg + 1u) * nx) xb_add(&bar[XB_TOPGEN], 1u);
            else XB_SPIN(xb_ld(&bar[XB_TOPGEN]) == tg, bar);
            __builtin_amdgcn_fence(__ATOMIC_ACQUIRE, "agent");
            xb_add(&bar[XB_XGEN(b.x)], 1u);
            asm volatile("s_waitcnt vmcnt(0)" ::: "memory");
        } else {
            XB_SPIN(xb_ld(&bar[XB_XGEN(b.x)]) == gen, bar);
            __builtin_amdgcn_fence(__ATOMIC_ACQUIRE, "agent");
            asm volatile("s_waitcnt vmcnt(0)" ::: "memory");
        }
    }
    __syncthreads();
}

struct Frame {
    LAS unsigned char* lds;
    int tid, lane, wave;
    int vcu, G, bid;
};
__device__ __forceinline__ float wave_sum(float v) { return pg8::wave_sum_f(v); }

template <bool F8>
__device__ __forceinline__ void transpose_item(const float* W, int ldw, int c0, int ncols, int K, int kb, void* WTv, int dst_row0, const float* kscale, LAS float* scr, int lane) {
    const int k0 = 64 * kb, n = lane & 31;
#pragma unroll 8
    for (int i = 0; i < 32; ++i) { const int kk = 2 * i + (lane >> 5);
        float v = 0.f;
        if (n < ncols) { v = __builtin_nontemporal_load(W + (size_t)(k0 + kk) * ldw + c0 + n); if (kscale) v *= kscale[k0 + kk]; }
        scr[kk * 33 + n] = v; }
    LDS_WAIT(); asm volatile("" ::: "memory");
    const int c = lane & 7;
#pragma unroll
    for (int j = 0; j < 4; ++j) { const int nn = (lane >> 3) + 8 * j; const LAS float* s = scr + (8 * c) * 33 + nn;
        if constexpr (F8) {
            v2u o; o.x = pg8::pk4_fp8(32.f * s[0 * 33], 32.f * s[1 * 33], 32.f * s[2 * 33], 32.f * s[3 * 33]); o.y = pg8::pk4_fp8(32.f * s[4 * 33], 32.f * s[5 * 33], 32.f * s[6 * 33], 32.f * s[7 * 33]);
            *(GAS v2u*)((unsigned char*)WTv + (size_t)(dst_row0 + nn) * K + k0 + 8 * c) = o;
        } else { bf16* WT = (bf16*)WTv;
            v4u o; o.x = pk2(s[0 * 33], s[1 * 33]); o.y = pk2(s[2 * 33], s[3 * 33]); o.z = pk2(s[4 * 33], s[5 * 33]); o.w = pk2(s[6 * 33], s[7 * 33]);
            *(GAS v4u*)(WT + (size_t)(dst_row0 + nn) * K + k0 + 8 * c) = o; } }
    LDS_WAIT(); asm volatile("" ::: "memory");
}
__device__ __forceinline__ void transpose_quad(const float* W, int ldw, int c0, int K, int kb, unsigned char* WT, int dst_row0, const float* kscale, LAS float* scr, int lane) {
    typedef float f32x4_ __attribute__((ext_vector_type(4)));
    const int k0 = 64 * kb, n4 = 4 * (lane & 31), kr = lane >> 5;
    f32x4_ v[32];
#pragma unroll
    for (int i = 0; i < 32; ++i) v[i] = *(const GAS f32x4_*)(W + (size_t)(k0 + 2 * i + kr) * ldw + c0 + n4);
    if (kscale) {
#pragma unroll
        for (int i = 0; i < 32; ++i) v[i] = v[i] * kscale[k0 + 2 * i + kr]; }
    const int c = lane & 7;
#pragma unroll
    for (int q = 0; q < 4; ++q) {
        if (((lane & 31) >> 3) == q) {
#pragma unroll
            for (int i = 0; i < 32; ++i) *(LAS f32x4_*)(scr + (2 * i + kr) * 36 + (n4 & 31)) = v[i]; }
        LDS_WAIT(); asm volatile("" ::: "memory");
#pragma unroll
        for (int j = 0; j < 4; ++j) { const int nn = (lane >> 3) + 8 * j; const LAS float* sp = scr + (8 * c) * 36 + nn;
            v2u o; o.x = pg8::pk4_fp8(32.f * sp[0 * 36], 32.f * sp[1 * 36], 32.f * sp[2 * 36], 32.f * sp[3 * 36]); o.y = pg8::pk4_fp8(32.f * sp[4 * 36], 32.f * sp[5 * 36], 32.f * sp[6 * 36], 32.f * sp[7 * 36]);
            *(GAS v2u*)(WT + (size_t)(dst_row0 + 32 * q + nn) * K + k0 + 8 * c) = o; }
        LDS_WAIT(); asm volatile("" ::: "memory");
    }
}
struct Ptrs {
    const float *x, *c, *w_ada, *b_ada, *norm_ffn1, *w_gate1, *w_up1, *w_down1, *norm_mix, *w_in, *qn_a, *kn_a, *qn_c, *kn_c, *g_out, *w_out, *norm_ffn2, *w_gate2, *w_up2, *w_down2;
    float* out; unsigned char* ws; int ph_lo, ph_hi;
};
constexpr int IT_GU = (NGU / 128) * (DM / 64), IT_D = (DM / 128) * (DFF / 64), IT_IN = (NPROJ / 32) * (DM / 64), IT_OUT = (DM / 128) * (DM / 64);
constexpr int IT_LAYER = 2 * IT_GU + 2 * IT_D + IT_IN + IT_OUT;
template <class KP>
__device__ __forceinline__ void p0_prologue(Frame& F, KP P) {
    {
        LAS float* sl = (LAS float*)F.lds;
        LAS float* part = (LAS float*)(F.lds + 32768);
        float* mod = (float*)(P->ws + WS_MOD);
        if (F.bid < 288) {
            for (int i = F.tid; i < NB * DM; i += NWAVES * 64) { const float cv = P->c[i]; sl[i] = cv / (1.0f + __expf(-cv)); }
            __syncthreads(); }
        for (int it = F.bid; it < 288; it += F.G) {
            const int l = it / 144, cb = it % 144, rsub = F.lane >> 4, c4 = 4 * (F.lane & 15);
            f32x4 acc[NB];
#pragma unroll
            for (int b = 0; b < NB; ++b) acc[b] = (f32x4){0.f, 0.f, 0.f, 0.f};
            const float* wp = P->w_ada + (size_t)l * DM * NMODC + 64 * cb + c4;
#pragma unroll 8
            for (int kk = 0; kk < 32; ++kk) { const int k = 128 * F.wave + 4 * kk + rsub; const f32x4 wv = __builtin_nontemporal_load((const GAS f32x4*)(wp + (size_t)k * NMODC));
#pragma unroll
                for (int b = 0; b < NB; ++b) acc[b] += wv * sl[b * DM + k]; }
#pragma unroll
            for (int b = 0; b < NB; ++b) { f32x4 t = acc[b];
                t.x = pg8::xsum32(pg8::xsum16(t.x)); t.y = pg8::xsum32(pg8::xsum16(t.y)); t.z = pg8::xsum32(pg8::xsum16(t.z)); t.w = pg8::xsum32(pg8::xsum16(t.w));
                if (rsub == 0) *(LAS f32x4*)(part + (F.wave * NB + b) * 64 + c4) = t; }
            __syncthreads();
            { const int o = F.tid, b = o >> 6, col = o & 63; float sum = P->b_ada[l * NMODC + 64 * cb + col];
#pragma unroll
              for (int w = 0; w < NWAVES; ++w) sum += part[(w * NB + b) * 64 + col];
              mod[(size_t)(l * NB + b) * NMODC + 64 * cb + col] = sum; }
            __syncthreads();
        }
    }
    LAS float* scr = (LAS float*)(F.lds + F.wave * 16384);
    const int gw = F.vcu * NWAVES + F.wave, NGW = F.G * NWAVES;
    for (int it0 = gw; it0 < 2 * IT_LAYER; it0 += NGW) {
        const int l = it0 / IT_LAYER; int it = it0 % IT_LAYER;
        unsigned char* wl = P->ws + WS_W + (size_t)l * LAYER_W_BYTES;
        if (it < 2 * (IT_GU + IT_D)) {
            const int f2 = it >= (IT_GU + IT_D); if (f2) it -= IT_GU + IT_D;
            const float* wg = (f2 ? P->w_gate2 : P->w_gate1) + (size_t)l * DM * DFF; const float* wu = (f2 ? P->w_up2 : P->w_up1) + (size_t)l * DM * DFF;
            const float* wd = (f2 ? P->w_down2 : P->w_down1) + (size_t)l * DFF * DM;
            if (it < IT_GU) { const int gq = it / (DM / 64), kb = it % (DM / 64), pn = gq >> 1;
                transpose_quad((gq & 1) ? wu : wg, DFF, 128 * pn, DM, kb, wl + (f2 ? OFF_WGU2 : OFF_WGU1), 128 * gq, nullptr, scr, F.lane); }
            else { it -= IT_GU; const int gq = it / (DFF / 64), kb = it % (DFF / 64);
                transpose_quad(wd, DM, 128 * gq, DFF, kb, wl + (f2 ? OFF_WD2 : OFF_WD1), 128 * gq, nullptr, scr, F.lane); }
            continue;
        }
        it -= 2 * (IT_GU + IT_D);
        if (it < IT_IN) { const int g = it / (DM / 64), kb = it % (DM / 64), pn = g >> 3, sub = g & 7, bj = sub >> 2, wc = sub & 3, pc0 = 256 * pn + 64 * wc + 32 * bj;
            int c0 = 0, nc = 32;
            if (pc0 < 768) c0 = pc0; else if (pc0 < 1536) c0 = pc0 - 768 + 1352; else if (pc0 < 3072) c0 = pc0 - 1536 + 2120; else if (pc0 < 3584) c0 = pc0 - 3072 + 768;
            else if (pc0 < 3648) c0 = pc0 - 3584 + 1280; else if (pc0 == 3648) { c0 = 1344; nc = 8; } else nc = 0;
            transpose_item<false>(P->w_in + (size_t)l * DM * WIN_COLS, WIN_COLS, c0, nc, DM, kb, wl + OFF_WIN, 32 * g, nullptr, scr, F.lane);
            continue; }
        it -= IT_IN;
        { const int gq = it / (DM / 64), kb = it % (DM / 64);
          transpose_quad(P->w_out + (size_t)l * DM * DM, DM, 128 * gq, DM, kb, wl + OFF_WOUT, 128 * gq, P->g_out + l * DM, scr, F.lane); }
    }
}

template <bool F8OUT, bool IN_BF16>
__device__ __forceinline__ void norm_mod_phase(Frame& F, const void* xsrc, const float* gain, const float* modl, int ch_shift, int ch_scale, void* houtv) {
    for (int rb = F.bid; rb < MTOK / 128; rb += F.G) {
        const int b = rb >> 5;
        const float* shp = modl + (size_t)b * NMODC + ch_shift * DM; const float* scp = modl + (size_t)b * NMODC + ch_scale * DM;
        f32x4 ga[4], sh[4];
#pragma unroll
        for (int j = 0; j < 4; ++j) { const int col = 4 * F.lane + 256 * j; const f32x4 g = *(const GAS f32x4*)(gain + col), s = *(const GAS f32x4*)(scp + col);
            ga[j] = g * (s + 1.0f); sh[j] = *(const GAS f32x4*)(shp + col); }
#pragma unroll 1
        for (int r0 = 0; r0 < 16; r0 += 4) { const int rowb = 128 * rb + 16 * F.wave + r0;
            f32x4 vv[4][4];
            if constexpr (IN_BF16) { v2u w[4][4];
#pragma unroll
                for (int k = 0; k < 4; ++k) { const GAS v2u* xr = (const GAS v2u*)((const bf16*)xsrc + (size_t)(rowb + k) * DM) + F.lane;
#pragma unroll
                    for (int j = 0; j < 4; ++j) w[k][j] = xr[64 * j]; }
#pragma unroll
                for (int k = 0; k < 4; ++k)
#pragma unroll
                    for (int j = 0; j < 4; ++j) vv[k][j] = (f32x4){__uint_as_float(w[k][j].x << 16), __uint_as_float(w[k][j].x & 0xffff0000u), __uint_as_float(w[k][j].y << 16), __uint_as_float(w[k][j].y & 0xffff0000u)}; }
            else {
#pragma unroll
                for (int k = 0; k < 4; ++k) { const GAS f32x4* xr = (const GAS f32x4*)((const float*)xsrc + (size_t)(rowb + k) * DM) + F.lane;
#pragma unroll
                    for (int j = 0; j < 4; ++j) vv[k][j] = xr[64 * j]; } }
#pragma unroll
            for (int k = 0; k < 4; ++k) { const int row = rowb + k; const f32x4 (&v)[4] = vv[k]; float ss = 0.f;
#pragma unroll
                for (int j = 0; j < 4; ++j) ss += (v[j].x * v[j].x + v[j].y * v[j].y) + (v[j].z * v[j].z + v[j].w * v[j].w);
                const float rstd = 1.0f / sqrtf(wave_sum(ss) * (1.0f / DM) + 1e-6f);
                if constexpr (F8OUT) { GAS unsigned* o4 = (GAS unsigned*)((unsigned char*)houtv + (size_t)row * DM) + F.lane;
#pragma unroll
                    for (int j = 0; j < 4; ++j) { const f32x4 y = v[j] * rstd * ga[j] + sh[j]; o4[64 * j] = pg8::pk4_fp8(y.x, y.y, y.z, y.w); } }
                else { GAS v2u* o8 = (GAS v2u*)((bf16*)houtv + (size_t)row * DM) + F.lane;
#pragma unroll
                    for (int j = 0; j < 4; ++j) { const f32x4 y = v[j] * rstd * ga[j] + sh[j]; v2u w; w.x = pk2(y.x, y.y); w.y = pk2(y.z, y.w); o8[64 * j] = w; } }
            }
        }
    }
}
__device__ __forceinline__ void group_norm_phase(Frame& F, const bf16* o, unsigned char* y8) {
    const int gw = F.bid * NWAVES + F.wave, NGW = F.G * NWAVES;
#pragma unroll 1
    for (int row0 = gw; row0 < MTOK; row0 += 4 * NGW) {
        v2u wq[4][4];
#pragma unroll
        for (int k = 0; k < 4; ++k) { const int row = row0 + k * NGW; const GAS v2u* orow = (const GAS v2u*)(o + (size_t)(row < MTOK ? row : row0) * DM) + F.lane;
#pragma unroll
            for (int j = 0; j < 4; ++j) wq[k][j] = orow[64 * j]; }
#pragma unroll
        for (int k = 0; k < 4; ++k) { const int row = row0 + k * NGW; if (row >= MTOK) break;
            float v[4][4], ss[4];
#pragma unroll
            for (int j = 0; j < 4; ++j) { const v2u w = wq[k][j]; v[j][0] = __uint_as_float(w.x << 16); v[j][1] = __uint_as_float(w.x & 0xffff0000u); v[j][2] = __uint_as_float(w.y << 16); v[j][3] = __uint_as_float(w.y & 0xffff0000u);
                ss[j] = wave_sum((v[j][0] * v[j][0] + v[j][1] * v[j][1]) + (v[j][2] * v[j][2] + v[j][3] * v[j][3])); }
            float rs[4];
            rs[0] = 1.0f / sqrtf(ss[0] * (1.0f / 256.f) + 1e-6f); rs[1] = 1.0f / sqrtf(ss[1] * (1.0f / 256.f) + 1e-6f); rs[2] = rs[3] = 1.0f / sqrtf((ss[2] + ss[3]) * (1.0f / 512.f) + 1e-6f);
            GAS unsigned* yrow = (GAS unsigned*)(y8 + (size_t)row * DM) + F.lane;
#pragma unroll
            for (int j = 0; j < 4; ++j) yrow[64 * j] = pg8::pk4_fp8(v[j][0] * rs[j], v[j][1] * rs[j], v[j][2] * rs[j], v[j][3] * rs[j]);
        }
    }
}

namespace att {
typedef float f32x16 __attribute__((ext_vector_type(16)));
typedef short s16x4 __attribute__((ext_vector_type(4)));
__device__ __forceinline__ int crow(int r, int hi) { return (r & 3) + 8 * (r >> 2) + 4 * hi; }
#define SBAR() __builtin_amdgcn_sched_barrier(0)
__device__ __forceinline__ void pv(f32x16* o, int vb, bf16x8 pa0, bf16x8 pa1, bf16x8 pa2, bf16x8 pa3) {
#pragma unroll
    for (int d0 = 0; d0 < 2; ++d0) { s16x4 lo[4], hi[4];
#pragma unroll
        for (int ks = 0; ks < 4; ++ks) {
            asm volatile("ds_read_b64_tr_b16 %0,%1 offset:%c2" : "=&v"(lo[ks]) : "v"(vb), "i"(d0 * 4096 + ks * 1024) : "memory");
            asm volatile("ds_read_b64_tr_b16 %0,%1 offset:%c2" : "=&v"(hi[ks]) : "v"(vb), "i"(d0 * 4096 + ks * 1024 + 512) : "memory"); }
        asm volatile("s_waitcnt lgkmcnt(0)" ::: "memory"); SBAR();
#define PK(k) (bf16x8){lo[k][0], lo[k][1], lo[k][2], lo[k][3], hi[k][0], hi[k][1], hi[k][2], hi[k][3]}
        __builtin_amdgcn_s_setprio(1);
        o[d0] = __builtin_amdgcn_mfma_f32_32x32x16_bf16(pa0, PK(0), o[d0], 0, 0, 0);
        o[d0] = __builtin_amdgcn_mfma_f32_32x32x16_bf16(pa1, PK(1), o[d0], 0, 0, 0);
        o[d0] = __builtin_amdgcn_mfma_f32_32x32x16_bf16(pa2, PK(2), o[d0], 0, 0, 0);
        o[d0] = __builtin_amdgcn_mfma_f32_32x32x16_bf16(pa3, PK(3), o[d0], 0, 0, 0);
        __builtin_amdgcn_s_setprio(0);
#undef PK
    }
}
__device__ __forceinline__ void qkt(f32x16& p0, f32x16& p1, const bf16x8 (&kf)[8], const bf16x8 (&qr)[4]) {
    p0 = (f32x16){}; p1 = (f32x16){};
#pragma unroll
    for (int d0 = 0; d0 < 4; ++d0) { p0 = __builtin_amdgcn_mfma_f32_32x32x16_bf16(kf[2 * d0], qr[d0], p0, 0, 0, 0); p1 = __builtin_amdgcn_mfma_f32_32x32x16_bf16(kf[2 * d0 + 1], qr[d0], p1, 0, 0, 0); }
}
__device__ __forceinline__ void load_k(bf16x8 (&kf)[8], const bf16* k0, const bf16* k1) {
#pragma unroll
    for (int d0 = 0; d0 < 4; ++d0) { kf[2 * d0] = *(const GAS bf16x8*)(k0 + 16 * d0); kf[2 * d0 + 1] = *(const GAS bf16x8*)(k1 + 16 * d0); }
}
__device__ __forceinline__ void stage_v(const bf16* v0, const bf16* v1, const bf16* v2, const bf16* v3, LAS unsigned char* slot) {
    const bf16* vg[4] = {v0, v1, v2, v3};
#pragma unroll
    for (int dh = 0; dh < 2; ++dh)
#pragma unroll
        for (int kg = 0; kg < 4; ++kg)
            __builtin_amdgcn_global_load_lds((const unsigned*)(vg[kg] + dh * 32), (LAS unsigned*)(slot + (dh * 4 + kg) * 1024), 16, 0, 0);
}
__device__ __forceinline__ float swap_max(float m) { auto rr = __builtin_amdgcn_permlane32_swap(__float_as_uint(m), __float_as_uint(m), false, false); return fmaxf(__uint_as_float(rr[0]), __uint_as_float(rr[1])); }
__device__ __forceinline__ float swap_sum(float m) { auto rr = __builtin_amdgcn_permlane32_swap(__float_as_uint(m), __float_as_uint(m), false, false); return __uint_as_float(rr[0]) + __uint_as_float(rr[1]); }
__device__ __forceinline__ float rowmax32(const f32x16& p0, const f32x16& p1) {
    float a = fmaxf(p0[0], p1[0]);
#pragma unroll
    for (int r = 1; r < 16; ++r) a = fmaxf(a, fmaxf(p0[r], p1[r]));
    return swap_max(a);
}
__device__ __forceinline__ void scale_rows(f32x16 (&o)[2], LAS float* wsf, float f, int r32, int hi) {
    if (hi == 0) wsf[r32] = f;
#pragma unroll
    for (int r = 0; r < 16; ++r) { const float fr = wsf[crow(r, hi)]; o[0][r] *= fr; o[1][r] *= fr; }
}
#define PACK4(P, B) (v4u){pk2(P[B], P[B + 1]), pk2(P[B + 2], P[B + 3]), pk2(P[B + 4], P[B + 5]), pk2(P[B + 6], P[B + 7])}
__device__ __forceinline__ void softmax_step(f32x16& p0, f32x16& p1, float& m, float& lsum, f32x16 (&o)[2], LAS float* wsf, int r32, int hi) {
    const float rm = rowmax32(p0, p1), mnew = fmaxf(m, rm);
    if (__any(mnew > m)) { const float f = __builtin_amdgcn_exp2f(m - mnew); lsum *= f; scale_rows(o, wsf, f, r32, hi); m = mnew; }
    float s = 0.f;
#pragma unroll
    for (int r = 0; r < 16; ++r) { p0[r] = __builtin_amdgcn_exp2f(p0[r] - m); p1[r] = __builtin_amdgcn_exp2f(p1[r] - m); s += p0[r] + p1[r]; }
    lsum += s;
}
__device__ __forceinline__ void softmax_step1(f32x16& p1, float& m, float& lsum, f32x16 (&o)[2], LAS float* wsf, int r32, int hi) {
    float a = p1[0];
#pragma unroll
    for (int r = 1; r < 16; ++r) a = fmaxf(a, p1[r]);
    const float rm = swap_max(a), mnew = fmaxf(m, rm);
    if (__any(mnew > m)) { const float f = __builtin_amdgcn_exp2f(m - mnew); lsum *= f; scale_rows(o, wsf, f, r32, hi); m = mnew; }
    float s = 0.f;
#pragma unroll
    for (int r = 0; r < 16; ++r) { p1[r] = __builtin_amdgcn_exp2f(p1[r] - m); s += p1[r]; }
    lsum += s;
}
__device__ __forceinline__ void pv_half(f32x16* o, int vb, bf16x8 pa2, bf16x8 pa3) {
#pragma unroll
    for (int d0 = 0; d0 < 2; ++d0) { s16x4 lo[2], hi[2];
#pragma unroll
        for (int ks = 0; ks < 2; ++ks) {
            asm volatile("ds_read_b64_tr_b16 %0,%1 offset:%c2" : "=&v"(lo[ks]) : "v"(vb), "i"(d0 * 4096 + (ks + 2) * 1024) : "memory");
            asm volatile("ds_read_b64_tr_b16 %0,%1 offset:%c2" : "=&v"(hi[ks]) : "v"(vb), "i"(d0 * 4096 + (ks + 2) * 1024 + 512) : "memory"); }
        asm volatile("s_waitcnt lgkmcnt(0)" ::: "memory"); SBAR();
#define PK(k) (bf16x8){lo[k][0], lo[k][1], lo[k][2], lo[k][3], hi[k][0], hi[k][1], hi[k][2], hi[k][3]}
        o[d0] = __builtin_amdgcn_mfma_f32_32x32x16_bf16(pa2, PK(0), o[d0], 0, 0, 0);
        o[d0] = __builtin_amdgcn_mfma_f32_32x32x16_bf16(pa3, PK(1), o[d0], 0, 0, 0);
#undef PK
    }
}
__device__ __forceinline__ void pv_tile(f32x16 (&o)[2], const f32x16& p0, const f32x16& p1, int vb) {
    const v4u w0 = PACK4(p0, 0), w1 = PACK4(p0, 8), w2 = PACK4(p1, 0), w3 = PACK4(p1, 8);
    asm volatile("s_waitcnt vmcnt(0)" ::: "memory");
    pv(o, vb, __builtin_bit_cast(bf16x8, w0), __builtin_bit_cast(bf16x8, w1), __builtin_bit_cast(bf16x8, w2), __builtin_bit_cast(bf16x8, w3));
}
struct WaveCtx { int lane, r32, hi, wid; LAS unsigned char* vslot; LAS float* wsf; int vb; };
__device__ __forceinline__ WaveCtx make_ctx(LAS unsigned char* lds, int slot_stride, int wave_id) {
    int lane_o = (int)__builtin_amdgcn_mbcnt_hi(~0u, __builtin_amdgcn_mbcnt_lo(~0u, 0u)); asm volatile("" : "+v"(lane_o));
    WaveCtx c; c.lane = lane_o; c.r32 = c.lane & 31; c.hi = c.lane >> 5; c.wid = wave_id;
    c.vslot = lds + c.wid * slot_stride; c.wsf = (LAS float*)(lds + EXTRA_OFF + 2048 + c.wid * 256);
    c.vb = (int)(unsigned)(uintptr_t)c.vslot + ((c.lane >> 4) & 1) * 32 + (c.lane & 3) * 8 + (4 * c.hi + ((c.lane & 15) >> 2)) * 64;
    return c;
}
__device__ __forceinline__ void store_o(const f32x16 (&o)[2], const WaveCtx& c, bf16* obuf, size_t row0, int col0, bool use_scale) {
#pragma unroll
    for (int r = 0; r < 16; ++r) { const int q = crow(r, c.hi); const float f = use_scale ? c.wsf[q] : 1.0f;
        bf16* op = obuf + (row0 + q) * DM + col0 + c.r32;
        op[0] = (bf16)(pk2(o[0][r] * f, 0.f) & 0xffffu); op[32] = (bf16)(pk2(o[1][r] * f, 0.f) & 0xffffu); }
}

__device__ __forceinline__ void load_k_t(bf16x8 (&kf)[8], const unsigned char* g0, const unsigned char* g1) {
#pragma unroll
    for (int d0 = 0; d0 < 4; ++d0) { kf[2 * d0] = *(const GAS bf16x8*)(g0 + d0 * 1024); kf[2 * d0 + 1] = *(const GAS bf16x8*)(g1 + d0 * 1024); }
}
__device__ __forceinline__ void stage_v_t(const unsigned char* v0, const unsigned char* v1, const unsigned char* v2, const unsigned char* v3, LAS unsigned char* slot) {
    const unsigned char* vg[4] = {v0, v1, v2, v3};
#pragma unroll
    for (int dh = 0; dh < 2; ++dh)
#pragma unroll
        for (int kg = 0; kg < 4; ++kg)
            __builtin_amdgcn_global_load_lds((const unsigned*)(vg[kg] + dh * 1024), (LAS unsigned*)(slot + (dh * 4 + kg) * 1024), 16, 0, 0);
}
constexpr size_t HB = pg8::EpiProj::HB;

__device__ __forceinline__ void attA_unit_s(int b, int h, int qb, const bf16* qbuf, const unsigned char* kv, const unsigned long long* maskw, bf16* obuf, LAS unsigned char* lds, float slope2, int wave_id) {
    const WaveCtx c = make_ctx(lds, 16384, wave_id);
    const int tq0 = 256 * qb + 32 * c.wid, t = tq0 + c.r32;
    const size_t rowbase = (size_t)b * SEQ;
    bf16x8 qr[4];
    { const bf16* Qp = qbuf + (rowbase + t) * QPITCH + QC_A + h * 64 + c.hi * 8;
#pragma unroll
      for (int d0 = 0; d0 < 4; ++d0) qr[d0] = *(const GAS bf16x8*)(Qp + 16 * d0); }
    const unsigned char* Ksrc = kv + pg8::EpiProj::KT_A + (size_t)(b * 4 + h) * HB + (size_t)(c.lane >> 5) * 4096 + c.wid * 512 + (c.lane & 31) * 16;
    const unsigned char* Vsrc = kv + pg8::EpiProj::VT_A + (size_t)(b * 4 + h) * HB + (size_t)(c.wid & 3) * 2048 + (c.wid >> 2) * 1024 + c.lane * 16;
    const unsigned long long* mwp = maskw + (size_t)b * 64 * SEQ + t;
    const int njw = (tq0 + 31) / 64 + 1, njb = 4 * qb + 4;
    LAS unsigned char* ring = lds;
    const int kfo = c.hi * 1024 + c.r32 * 16, vbo = ((c.lane >> 4) & 1) * 32 + (c.lane & 3) * 8 + (4 * c.hi + ((c.lane & 15) >> 2)) * 64;
#define ATA_DMA(J) do { LAS unsigned char* sl_ = ring + ((J) & 3) * 16384; \
        __builtin_amdgcn_global_load_lds((const unsigned*)(Ksrc + (size_t)(J) * 8192), (LAS unsigned*)(sl_ + c.wid * 1024), 16, 0, 0); \
        __builtin_amdgcn_global_load_lds((const unsigned*)(Vsrc + (size_t)(J) * 8192), (LAS unsigned*)(sl_ + 8192 + c.wid * 1024), 16, 0, 0); } while (0)
    float m = -1e30f, lsum = 0.f; f32x16 o[2]; o[0] = (f32x16){}; o[1] = (f32x16){};
    f32x16 bq0, bq1;
#pragma unroll
    for (int r = 0; r < 16; ++r) { const int cr = (r & 3) + 8 * (r >> 2); bq0[r] = slope2 * (float)(cr + 4 * c.hi - t); bq1[r] = slope2 * (float)(cr + 32 + 4 * c.hi - t); }
    const float fshift = 64.0f * slope2;
#define ATA_QK(J, P0, P1) do { const LAS unsigned char* ks_ = ring + ((J) & 3) * 16384 + kfo; bf16x8 kf_[8]; \
        _Pragma("unroll") for (int d0 = 0; d0 < 4; ++d0) { kf_[2 * d0] = *(const LAS bf16x8*)(ks_ + d0 * 2048); kf_[2 * d0 + 1] = *(const LAS bf16x8*)(ks_ + d0 * 2048 + 512); } \
        P0 = bq0; P1 = bq1; \
        _Pragma("unroll") for (int d0 = 0; d0 < 4; ++d0) { P0 = __builtin_amdgcn_mfma_f32_32x32x16_bf16(kf_[2 * d0], qr[d0], P0, 0, 0, 0); P1 = __builtin_amdgcn_mfma_f32_32x32x16_bf16(kf_[2 * d0 + 1], qr[d0], P1, 0, 0, 0); } } while (0)
    asm volatile("s_waitcnt lgkmcnt(0)\n\ts_barrier" ::: "memory");
    unsigned long long mw = mwp[0], mwn = 0ull;
    __builtin_amdgcn_sched_barrier(0);
    ATA_DMA(0); ATA_DMA(1); ATA_DMA(2);
    asm volatile("s_waitcnt vmcnt(4)\n\ts_barrier" ::: "memory");
    f32x16 p0, p1;
    ATA_QK(0, p0, p1);
#define ATA_ITER(DO_QK, DO_SM) do { \
        if (j + 1 < njb) {                                                              \
              \
              \
            if (j + 2 >= njb) asm volatile("s_waitcnt vmcnt(0)\n\ts_barrier" ::: "memory"); \
            else if (j == 0 || !((DO_QK) || (DO_SM))) asm volatile("s_waitcnt vmcnt(2)\n\ts_barrier" ::: "memory"); \
            else if (j == 1) asm volatile("s_waitcnt vmcnt(3)\n\ts_barrier" ::: "memory"); \
            else asm volatile("s_waitcnt vmcnt(4)\n\ts_barrier" ::: "memory"); } \
        if (j + 3 < njb) ATA_DMA(j + 3);                                                \
        if (DO_QK) { __builtin_amdgcn_sched_barrier(0); mwn = mwp[(size_t)(j + 1) * SEQ]; __builtin_amdgcn_sched_barrier(0); }        \
        f32x16 n0, n1; \
        if (DO_QK) ATA_QK(j + 1, n0, n1); \
        if (DO_SM) { \
            m -= fshift;                                                                \
            unsigned wv = c.hi ? (unsigned)(mw >> 32) : (unsigned)mw;                   \
            _Pragma("unroll") for (int r = 0; r < 16; ++r) { unsigned nw; const bool cy = __builtin_uadd_overflow(wv, wv, &nw); wv = nw; p0[r] = cy ? p0[r] : -INFINITY; } \
            _Pragma("unroll") for (int r = 0; r < 16; ++r) { unsigned nw; const bool cy = __builtin_uadd_overflow(wv, wv, &nw); wv = nw; p1[r] = cy ? p1[r] : -INFINITY; } \
            softmax_step(p0, p1, m, lsum, o, c.wsf, c.r32, c.hi); \
            const v4u w0 = PACK4(p0, 0), w1 = PACK4(p0, 8), w2 = PACK4(p1, 0), w3 = PACK4(p1, 8); \
            pv(o, (int)(unsigned)(uintptr_t)(ring + (j & 3) * 16384 + 8192) + vbo, __builtin_bit_cast(bf16x8, w0), __builtin_bit_cast(bf16x8, w1), __builtin_bit_cast(bf16x8, w2), __builtin_bit_cast(bf16x8, w3)); } \
        if (DO_QK) { p0 = n0; p1 = n1; } \
        mw = mwn; } while (0)
    int j = 0;
#pragma unroll 1
    for (; j + 1 < njw; ++j) ATA_ITER(true, true);
    ATA_ITER(false, true); ++j;
#pragma unroll 1
    for (; j < njb; ++j) ATA_ITER(false, false);
#undef ATA_ITER
#undef ATA_QK
#undef ATA_DMA
    const float l = swap_sum(lsum);
    if (c.hi == 0) c.wsf[c.r32] = 1.0f / l;
    store_o(o, c, obuf, rowbase + tq0, h * 64, true);
}

__device__ __forceinline__ void attB_unit(int b, int h, int qb, const bf16* qbuf, const unsigned char* kv, bf16* obuf, LAS unsigned char* lds, int wave_id) {
    const WaveCtx c = make_ctx(lds, 16384, wave_id);
    const int tq0 = 256 * qb + 32 * c.wid, t = tq0 + c.r32;
    const size_t rowbase = (size_t)b * SEQ;
    bf16x8 qr[4];
    { const bf16* Qp = qbuf + (rowbase + t) * QPITCH + QC_B + h * 64 + c.hi * 8;
#pragma unroll
      for (int d0 = 0; d0 < 4; ++d0) qr[d0] = *(const GAS bf16x8*)(Qp + 16 * d0); }
    const unsigned char* Kl = kv + pg8::EpiProj::KT_B + (size_t)(b * 4 + h) * HB + c.hi * 512 + c.r32 * 16;
    const unsigned char* Vl = kv + pg8::EpiProj::VT_B + (size_t)(b * 4 + h) * HB + c.lane * 16;
    const int jd = tq0 >> 6;
    float R = 0.f; f32x16 o[2]; o[0] = (f32x16){}; o[1] = (f32x16){};
    bf16x8 kf[8], kn[8];
    { const unsigned char* kt = Kl + (size_t)jd * 8192; load_k_t(kf, kt, kt + 4096);
      const unsigned char* vt = Vl + (size_t)jd * 8192; stage_v_t(vt, vt + 2048, vt + 4096, vt + 6144, c.vslot + (jd & 1) * 8192); }
    for (int j = jd; j >= 0; --j) {
        const bool more = (j > 0);
        if (more) { const unsigned char* kt = Kl + (size_t)(j - 1) * 8192; load_k_t(kn, kt, kt + 4096);
            const unsigned char* vt = Vl + (size_t)(j - 1) * 8192; stage_v_t(vt, vt + 2048, vt + 4096, vt + 6144, c.vslot + ((j - 1) & 1) * 8192); }
        f32x16 z0, z1; qkt(z0, z1, kf, qr);
        f32x16 L0, L1;
#pragma unroll
        for (int r = 0; r < 16; ++r) {
            L0[r] = -(fmaxf(z0[r], 0.f) + __builtin_amdgcn_logf(1.0f + __builtin_amdgcn_exp2f(-fabsf(z0[r]))));
            L1[r] = -(fmaxf(z1[r], 0.f) + __builtin_amdgcn_logf(1.0f + __builtin_amdgcn_exp2f(-fabsf(z1[r])))); }
        const bool diag = (j == jd);
        if (diag) {
#pragma unroll
            for (int r = 0; r < 16; ++r) { const int s = 64 * j + crow(r, c.hi); if (!(s < t)) L0[r] = 0.f; if (!(s + 32 < t)) L1[r] = 0.f; }
        }
        float gs[8], T[8], pr[8];
#pragma unroll
        for (int k = 0; k < 4; ++k) { gs[k] = (L0[4 * k] + L0[4 * k + 1]) + (L0[4 * k + 2] + L0[4 * k + 3]); gs[k + 4] = (L1[4 * k] + L1[4 * k + 1]) + (L1[4 * k + 2] + L1[4 * k + 3]); }
#pragma unroll
        for (int k = 0; k < 8; ++k) { auto rr = __builtin_amdgcn_permlane32_swap(__float_as_uint(gs[k]), __float_as_uint(gs[k]), false, false);
            const float lo = __uint_as_float(rr[0]), hv = __uint_as_float(rr[1]); T[k] = lo + hv; pr[k] = c.hi ? lo : hv; }
        float ST = 0.f;
#pragma unroll
        for (int k = 7; k >= 0; --k) {
            const float E = R + ST + (c.hi == 0 ? pr[k] : 0.f);
            if (k >= 4) { const int b4 = 4 * (k - 4);
                const float c3 = E, c2 = c3 + L1[b4 + 3], c1 = c2 + L1[b4 + 2], c0 = c1 + L1[b4 + 1];
                z1[b4 + 3] = __builtin_amdgcn_exp2f(z1[b4 + 3] + L1[b4 + 3] + c3); z1[b4 + 2] = __builtin_amdgcn_exp2f(z1[b4 + 2] + L1[b4 + 2] + c2);
                z1[b4 + 1] = __builtin_amdgcn_exp2f(z1[b4 + 1] + L1[b4 + 1] + c1); z1[b4] = __builtin_amdgcn_exp2f(z1[b4] + L1[b4] + c0);
            } else { const int b4 = 4 * k;
                const float c3 = E, c2 = c3 + L0[b4 + 3], c1 = c2 + L0[b4 + 2], c0 = c1 + L0[b4 + 1];
                z0[b4 + 3] = __builtin_amdgcn_exp2f(z0[b4 + 3] + L0[b4 + 3] + c3); z0[b4 + 2] = __builtin_amdgcn_exp2f(z0[b4 + 2] + L0[b4 + 2] + c2);
                z0[b4 + 1] = __builtin_amdgcn_exp2f(z0[b4 + 1] + L0[b4 + 1] + c1); z0[b4] = __builtin_amdgcn_exp2f(z0[b4] + L0[b4] + c0);
            }
            ST += T[k];
        }
        R += ST;
        if (diag) {
#pragma unroll
            for (int r = 0; r < 16; ++r) { const int s = 64 * j + crow(r, c.hi); if (!(s < t)) z0[r] = 0.f; if (!(s + 32 < t)) z1[r] = 0.f; }
        }
        pv_tile(o, z0, z1, c.vb + (j & 1) * 8192);
        if (__all(R < -150.0f)) break;
        if (more) {
#pragma unroll
            for (int i = 0; i < 8; ++i) kf[i] = kn[i]; }
    }
    asm volatile("s_waitcnt vmcnt(0)" ::: "memory");
    store_o(o, c, obuf, rowbase + tq0, 256 + h * 64, false);
}

__device__ __forceinline__ void attC_unit(int b, int h, int blk, const bf16* qbuf, const unsigned char* kv, bf16* obuf, LAS unsigned char* lds, float slope2, int wave_id) {
    const WaveCtx c = make_ctx(lds, 8192, wave_id);
    LAS bf16* oacc = (LAS bf16*)(lds + 65536); LAS float* lse = (LAS float*)(lds + EXTRA_OFF);
    const int T0 = 512 * blk; const size_t rowbase = (size_t)b * SEQ;
    unsigned wm0 = 0u, wm2 = 0u;
#pragma unroll
    for (int r = 0; r < 16; ++r) { wm0 |= (crow(r, c.hi) >= c.r32 ? 1u : 0u) << (31 - r); wm2 |= (crow(r, c.hi) <= c.r32 ? 1u : 0u) << (31 - r); }
#pragma unroll 1
    for (int br = 0; br < 3; ++br) {
        const int sh = 2 * br; const float sl2 = slope2 * (float)(1 << sh);
        f32x16 bq0; const float b32 = 32.0f * sl2;
#pragma unroll
        for (int r = 0; r < 16; ++r) bq0[r] = sl2 * (float)(crow(r, c.hi) - c.r32);
        const unsigned char* Kl = kv + pg8::EpiProj::KT_C + (size_t)br * pg8::EpiProj::DSTRIDE + (size_t)(b * 8 + h) * HB + c.hi * 512 + c.r32 * 16;
        const unsigned char* Vl = kv + pg8::EpiProj::VT_C + (size_t)(b * 8 + h) * HB + (c.lane & 3) * 16;
#pragma unroll 1
        for (int jj = 0; jj < 2; ++jj) {
            const int jt = c.wid + 8 * jj;
            int cc, u0;
            if (br == 0) { cc = 0; u0 = T0 + 32 * jt; } else if (br == 1) { cc = jt & 3; u0 = (T0 >> 2) + 32 * (jt >> 2); } else { cc = jt; u0 = T0 >> 4; }
            const int qu = u0 + c.r32, t = cc + (qu << sh);
            const int pc0 = cc << (12 - sh);
            bf16x8 qr[4];
            { const bf16* Qp = qbuf + (rowbase + t) * QPITCH + QC_C + h * 64 + c.hi * 8;
#pragma unroll
              for (int d0 = 0; d0 < 4; ++d0) qr[d0] = *(const GAS bf16x8*)(Qp + 16 * d0); }
            float m = -1e30f, lsum = 0.f; f32x16 o[2]; o[0] = (f32x16){}; o[1] = (f32x16){};
            const int g1 = (160 - u0) > 32 ? ((160 - u0) >> 5) : 1;
            bf16x8 kf[8];
            if (g1 == 1) {
                const int ku0 = u0 - 160;
                { const unsigned char* g1p = Kl + (size_t)((pc0 + ku0 + 32) >> 5) * 4096;
#pragma unroll
                  for (int d0 = 0; d0 < 4; ++d0) kf[2 * d0 + 1] = *(const GAS bf16x8*)(g1p + d0 * 1024); }
#pragma unroll
                for (int kg = 2; kg < 4; ++kg) { const int kvs = ku0 + 16 * kg + (c.lane >> 2), p = cc + (kvs << sh); const unsigned char* vg = Vl + (size_t)(p >> 4) * 2048 + (p & 15) * 64;
#pragma unroll
                    for (int dh = 0; dh < 2; ++dh) __builtin_amdgcn_global_load_lds((const unsigned*)(vg + dh * 1024), (LAS unsigned*)(c.vslot + (dh * 4 + kg) * 1024), 16, 0, 0); }
                f32x16 p1;
#pragma unroll
                for (int r = 0; r < 16; ++r) p1[r] = bq0[r] + b32;
#pragma unroll
                for (int d0 = 0; d0 < 4; ++d0) p1 = __builtin_amdgcn_mfma_f32_32x32x16_bf16(kf[2 * d0 + 1], qr[d0], p1, 0, 0, 0);
                __builtin_amdgcn_sched_barrier(0);
                load_k_t(kf, Kl + (size_t)((pc0 + ku0 + 64) >> 5) * 4096, Kl + (size_t)((pc0 + ku0 + 96) >> 5) * 4096);
                { unsigned wv = wm0;
#pragma unroll
                  for (int r = 0; r < 16; ++r) { unsigned nw; const bool cy = __builtin_uadd_overflow(wv, wv, &nw); wv = nw; p1[r] = cy ? p1[r] : -INFINITY; } }
                softmax_step1(p1, m, lsum, o, c.wsf, c.r32, c.hi);
                const v4u w2 = PACK4(p1, 0), w3 = PACK4(p1, 8);
                asm volatile("s_waitcnt vmcnt(8)" ::: "memory");
                pv_half(o, c.vb, __builtin_bit_cast(bf16x8, w2), __builtin_bit_cast(bf16x8, w3));
            } else {
                const int kts = g1 >> 1, ka = u0 - 160 + 64 * kts;
                load_k_t(kf, Kl + (size_t)((pc0 + (ka < 0 ? 0 : ka)) >> 5) * 4096, Kl + (size_t)((pc0 + ka + 32) >> 5) * 4096);
            }
#pragma unroll 1
            for (int kt = (g1 == 1 ? 1 : (g1 >> 1)); kt < 3; ++kt) {
                const int ku0 = u0 - 160 + 64 * kt;
                const bool p0dead = (g1 == 2 * kt + 1);
                m -= 64.0f * sl2;
                f32x16 p0 = bq0, p1;
#pragma unroll
                for (int r = 0; r < 16; ++r) p1[r] = bq0[r] + b32;
#pragma unroll
                for (int d0 = 0; d0 < 4; ++d0) { p0 = __builtin_amdgcn_mfma_f32_32x32x16_bf16(kf[2 * d0], qr[d0], p0, 0, 0, 0); p1 = __builtin_amdgcn_mfma_f32_32x32x16_bf16(kf[2 * d0 + 1], qr[d0], p1, 0, 0, 0); }
                { const unsigned char* vg[4];
#pragma unroll
                  for (int kg = 0; kg < 4; ++kg) { const int kvs = ku0 + 16 * kg + (c.lane >> 2), p = cc + ((kvs < 0 ? 0 : kvs) << sh);
                      vg[kg] = Vl + (size_t)(p >> 4) * 2048 + (p & 15) * 64; }
                  stage_v_t(vg[0], vg[1], vg[2], vg[3], c.vslot); }
                __builtin_amdgcn_sched_barrier(0);
                if (kt < 2) { const int ka = ku0 + 64; load_k_t(kf, Kl + (size_t)((pc0 + ka) >> 5) * 4096, Kl + (size_t)((pc0 + ka + 32) >> 5) * 4096); }
                if (p0dead) {
#pragma unroll
                    for (int r = 0; r < 16; ++r) p0[r] = -INFINITY; }
                if (kt == 2) { unsigned wv = wm2;
#pragma unroll
                    for (int r = 0; r < 16; ++r) { unsigned nw; const bool cy = __builtin_uadd_overflow(wv, wv, &nw); wv = nw; p1[r] = cy ? p1[r] : -INFINITY; } }
                softmax_step(p0, p1, m, lsum, o, c.wsf, c.r32, c.hi);
                const v4u w0 = PACK4(p0, 0), w1 = PACK4(p0, 8), w2 = PACK4(p1, 0), w3 = PACK4(p1, 8);
                if (kt < 2) asm volatile("s_waitcnt vmcnt(8)" ::: "memory"); else asm volatile("s_waitcnt vmcnt(0)" ::: "memory");
                pv(o, c.vb, __builtin_bit_cast(bf16x8, w0), __builtin_bit_cast(bf16x8, w1), __builtin_bit_cast(bf16x8, w2), __builtin_bit_cast(bf16x8, w3));
            }
            const float l = swap_sum(lsum), lb = m - 32.0f * sl2 + __builtin_amdgcn_logf(l);
            const int tl = t - T0;
            if (c.hi == 0) { c.wsf[c.r32] = 1.0f / l; c.wsf[32 + c.r32] = lb; }
            float lnew = lb;
            if (br > 0) { const float lo = lse[tl], mx = fmaxf(lo, lb); lnew = mx + __builtin_amdgcn_logf(__builtin_amdgcn_exp2f(lo - mx) + __builtin_amdgcn_exp2f(lb - mx)); }
#pragma unroll
            for (int r = 0; r < 16; ++r) { const int q = crow(r, c.hi); const int tlr = cc + ((u0 + q) << sh) - T0;
                const float inv = c.wsf[q]; float v0 = o[0][r] * inv, v1 = o[1][r] * inv;
                if (br > 0) { const float lbr = c.wsf[32 + q], lo = lse[tlr], mx = fmaxf(lo, lbr), eo = __builtin_amdgcn_exp2f(lo - mx), eb = __builtin_amdgcn_exp2f(lbr - mx), rd = 1.0f / (eo + eb);
                    const float wo = eo * rd, wb = eb * rd;
                    v0 = wo * bf2f(oacc[tlr * 64 + c.r32]) + wb * v0; v1 = wo * bf2f(oacc[tlr * 64 + 32 + c.r32]) + wb * v1; }
                if (br < 2) { oacc[tlr * 64 + c.r32] = (bf16)(pk2(v0, 0.f) & 0xffffu); oacc[tlr * 64 + 32 + c.r32] = (bf16)(pk2(v1, 0.f) & 0xffffu); }
                else { bf16* op = obuf + (rowbase + T0 + tlr) * DM + 512 + h * 64 + c.r32; op[0] = (bf16)(pk2(v0, 0.f) & 0xffffu); op[32] = (bf16)(pk2(v1, 0.f) & 0xffffu); }
            }
            LDS_WAIT();
            if (br < 2 && c.hi == 0) lse[tl] = lnew;
        }
        __syncthreads();
    }
}
#undef SBAR
}

__device__ __forceinline__ unsigned mask_e16(unsigned X) { return (X & 0xFu) | ((X >> 4) & 0xF0u) | ((X >> 8) & 0xF00u) | ((X >> 12) & 0xF000u); }
__device__ __forceinline__ unsigned long long mask_perm(unsigned lo, unsigned hi) {
    const unsigned w0 = __builtin_bitreverse32(mask_e16(lo) | (mask_e16(hi) << 16)), w1 = __builtin_bitreverse32(mask_e16(lo >> 4) | (mask_e16(hi >> 4) << 16));
    return ((unsigned long long)w1 << 32) | w0;
}
__device__ __forceinline__ int row_sum_dpp(int v) {
    v += __builtin_amdgcn_update_dpp(0, v, 0xB1, 0xF, 0xF, true); v += __builtin_amdgcn_update_dpp(0, v, 0x4E, 0xF, 0xF, true);
    v += __builtin_amdgcn_update_dpp(0, v, 0x141, 0xF, 0xF, true); v += __builtin_amdgcn_update_dpp(0, v, 0x140, 0xF, 0xF, true);
    return v;
}
constexpr int IDX_R = 3, IDX_STAGE = 16384;
#define IDX_NG 32
__device__ __forceinline__ void idx_phase(Frame& F, const bf16* qbuf, const unsigned char* kv, const float* wi32, unsigned long long* maskw, unsigned long long& pt_acc, unsigned long long& pt_t0) {
    typedef float f32x4_ __attribute__((ext_vector_type(4)));
    const int lane = F.lane, l15 = lane & 15, lg = lane >> 4, half = lane >> 5, l31 = lane & 31, wid = F.wave;
    LAS unsigned char* ring = F.lds;
    LAS unsigned* candl = (LAS unsigned*)(F.lds + EXTRA_OFF + 2048 + wid * 256);
    LAS unsigned long long* mstage = (LAS unsigned long long*)(F.lds + 65536);
    LAS unsigned char* qstage = F.lds + 73728 + wid * 3072;
    bool pref = false;
    float zA0 = 1.2f, zA1 = 1.2f;
    (void)pt_acc; (void)pt_t0;
#ifdef ITER_PROBE
    unsigned* itcnt = (unsigned*)maskw - 0; itcnt = (unsigned*)((unsigned char*)kv - (WS_KV - WS_CTL)) + 2048 + 16;
#endif
#pragma unroll 1
    for (int u = F.bid; u < NB * 256; u += F.G) {
        PT_START(6);
        const int b = u >> 8, rb = u & 255, qg = (b & 1) ? 255 - rb : rb, t0 = 16 * qg, upar = b & 1;
        const size_t rowbase = (size_t)b * SEQ;
        const int tq = t0 + 2 * wid + half;
        unsigned mAlo = 0u, mAhi = 0u, mBlo = 0u, mBhi = 0u;
        if (t0 + 15 < 256) {
#pragma unroll
            for (int j = 0; j < 4; ++j) { const unsigned long long ma = __ballot(64 * j + lane <= t0 + 2 * wid), mb = __ballot(64 * j + lane <= t0 + 2 * wid + 1);
                if (lane == j) { mAlo = (unsigned)ma; mAhi = (unsigned)(ma >> 32); mBlo = (unsigned)mb; mBhi = (unsigned)(mb >> 32); } }
        } else {
            const int nst = (t0 + 16 + 127) >> 7;
            bf16x8 qf[2]; f32x4_ wq;
            const unsigned char* ksrc = kv + pg8::EpiProj::KT_I + (size_t)b * pg8::EpiProj::HB + (size_t)(lane >> 5) * 4096 + l31 * 16;
#define IDX_DMAP(KS, S) do { _Pragma("unroll") for (int dd = 0; dd < 2; ++dd) { const int p_ = wid * 2 + dd, hf_ = p_ >> 3, c_ = p_ & 7; \
                __builtin_amdgcn_global_load_lds((const unsigned*)((KS) + (size_t)(S) * 16384 + hf_ * 8192 + c_ * 512), (LAS unsigned*)(ring + ((S) % IDX_R) * IDX_STAGE + hf_ * 8192 + c_ * 1024), 16, 0, 0); } } while (0)
#define IDX_DMA(S) IDX_DMAP(ksrc, S)
#define IDX_QDMA(RB, T0_) do { const bf16* qp_ = qbuf + ((RB) + (T0_) + 2 * wid + (l15 >> 3)) * QPITCH + QC_I + (l15 & 7) * 64 + 8 * lg; \
                __builtin_amdgcn_global_load_lds((const unsigned*)qp_, (LAS unsigned*)qstage, 16, 0, 0); __builtin_amdgcn_global_load_lds((const unsigned*)(qp_ + 32), (LAS unsigned*)(qstage + 1024), 16, 0, 0); \
                __builtin_amdgcn_global_load_lds((const unsigned*)(wi32 + ((RB) + (T0_) + 2 * wid + half) * 8 + 4 * (lg & 1)), (LAS unsigned*)(qstage + 2048), 16, 0, 0); } while (0)
            unsigned x[4 * IDX_NG]; float ssum = 0.f, ssq = 0.f;
#ifndef IDX2_REP_SCORE
#define IDX2_REP_SCORE 1
#endif
#ifndef IDX2_REP_SEL
#define IDX2_REP_SEL 1
#endif
            PT_STOP(6); PT_START(1);
            _Pragma("unroll 1") for (int reps_ = 0; reps_ < IDX2_REP_SCORE; ++reps_) {
            if (!pref) {
                asm volatile("s_waitcnt lgkmcnt(0)\n\ts_barrier" ::: "memory");
                IDX_QDMA(rowbase, t0); IDX_DMA(0); IDX_DMA(1); }
            asm volatile("s_waitcnt vmcnt(4)" ::: "memory");
            qf[0] = *(const LAS bf16x8*)(qstage + lane * 16); qf[1] = *(const LAS bf16x8*)(qstage + 1024 + lane * 16); wq = *(const LAS f32x4_*)(qstage + 2048 + lane * 16);
            LDS_WAIT();
#pragma unroll
            for (int s = 0; s < IDX_NG; ++s) {
                if (s < nst) {
                    if (s + 1 < nst) asm volatile("s_waitcnt vmcnt(2)\n\ts_barrier" ::: "memory"); else asm volatile("s_waitcnt vmcnt(0)\n\ts_barrier" ::: "memory");
                    const LAS unsigned char* slot = ring + (s % IDX_R) * IDX_STAGE + lg * 1024 + l15 * 16;
#define IDX_LDF(FR, J) do { _Pragma("unroll") for (int tt = 0; tt < 2; ++tt) { const int k64 = (32 * (J) + 16 * tt) & 63, hf = (32 * (J) + 16 * tt) >> 6; \
                        FR[2 * tt] = *(const LAS bf16x8*)(slot + hf * 8192 + k64 * 16); FR[2 * tt + 1] = *(const LAS bf16x8*)(slot + hf * 8192 + 4096 + k64 * 16); } } while (0)
                    bf16x8 fa[4], fb[4];
                    IDX_LDF(fa, 0);
#pragma unroll
                    for (int j = 0; j < 4; ++j) {
                        if (j + 1 < 4) { if (j & 1) IDX_LDF(fa, j + 1); else IDX_LDF(fb, j + 1); }
                        if ((j & 1) == 0) __builtin_amdgcn_sched_barrier(0);
                        float part[2];
#pragma unroll
                        for (int tt = 0; tt < 2; ++tt) {
                            const bf16x8 b0 = (j & 1) ? fb[2 * tt] : fa[2 * tt], b1 = (j & 1) ? fb[2 * tt + 1] : fa[2 * tt + 1];
                            f32x4_ acc = __builtin_amdgcn_mfma_f32_16x16x32_bf16(qf[0], b0, (f32x4_){0.f, 0.f, 0.f, 0.f}, 0, 0, 0);
                            acc = __builtin_amdgcn_mfma_f32_16x16x32_bf16(qf[1], b1, acc, 0, 0, 0);
                            const float r0_ = __int_as_float(max(__float_as_int(acc[0]), 0)), r1_ = __int_as_float(max(__float_as_int(acc[1]), 0)), r2_ = __int_as_float(max(__float_as_int(acc[2]), 0)), r3_ = __int_as_float(max(__float_as_int(acc[3]), 0));
                            part[tt] = fmaf(wq[3], r3_, fmaf(wq[2], r2_, fmaf(wq[1], r1_, wq[0] * r0_))); }
                        auto sw = __builtin_amdgcn_permlane16_swap(__float_as_uint(part[0]), __float_as_uint(part[1]), false, false);
                        const float v = (__uint_as_float(sw[0]) + __uint_as_float(sw[1])) + 0.0f;
                        unsigned uu = __float_as_uint(v); uu ^= ((unsigned)((int)uu >> 31) & 0x7FFFFFFFu);
                        const bool vld = (128 * (s + 1) <= t0 || 128 * s + 32 * j + l31 <= tq);
                        x[4 * s + j] = vld ? uu : 0x80000000u;
                        const float vz = vld ? v : 0.f; ssum += vz; ssq = fmaf(vz, vz, ssq);
                        if (j == 1 && s + 2 < nst) IDX_DMA(s + 2);
                    }
#undef IDX_LDF
                } else {
#pragma unroll
                    for (int j = 0; j < 4; ++j) x[4 * s + j] = 0x80000000u;
                }
            }
            }
            pref = false;
            { const int un = u + F.G;
              if (un < NB * 256) { const int bn = un >> 8, rbn = un & 255, qgn = (bn & 1) ? 255 - rbn : rbn, t0n = 16 * qgn;
                  if (t0n + 15 >= 256) {
                      asm volatile("s_waitcnt lgkmcnt(0)\n\ts_barrier" ::: "memory");
                      const unsigned char* ksn = kv + pg8::EpiProj::KT_I + (size_t)bn * pg8::EpiProj::HB + (size_t)(lane >> 5) * 4096 + l31 * 16;
                      IDX_QDMA((size_t)bn * SEQ, t0n); IDX_DMAP(ksn, 0); IDX_DMAP(ksn, 1); pref = true; } } }
            PT_STOP(1);
#undef IDX_DMA
#undef IDX_DMAP
#undef IDX_QDMA
            const int nb32 = (nst + 7) >> 3;
#define IDX_COUNT_LT(GV, CA, CB) do { unsigned cl_ = 0u; \
                _Pragma("unroll") for (int bq = 0; bq < 4; ++bq) if (bq < nb32) { unsigned a0_ = 0u, a1_ = 0u, a2_ = 0u, a3_ = 0u; \
                    _Pragma("unroll") for (int jq = 0; jq < 32; jq += 4) { \
                        a0_ = __builtin_amdgcn_alignbit(a0_, (unsigned)__builtin_elementwise_sub_sat((int)x[32 * bq + jq], (GV)), 31); a1_ = __builtin_amdgcn_alignbit(a1_, (unsigned)__builtin_elementwise_sub_sat((int)x[32 * bq + jq + 1], (GV)), 31); \
                        a2_ = __builtin_amdgcn_alignbit(a2_, (unsigned)__builtin_elementwise_sub_sat((int)x[32 * bq + jq + 2], (GV)), 31); a3_ = __builtin_amdgcn_alignbit(a3_, (unsigned)__builtin_elementwise_sub_sat((int)x[32 * bq + jq + 3], (GV)), 31); } \
                    cl_ += __builtin_popcount(a0_) + __builtin_popcount(a1_) + __builtin_popcount(a2_) + __builtin_popcount(a3_); } \
                const int rs_ = row_sum_dpp((int)cl_); \
                CA = __builtin_amdgcn_readlane(rs_, 0) + __builtin_amdgcn_readlane(rs_, 16); CB = __builtin_amdgcn_readlane(rs_, 32) + __builtin_amdgcn_readlane(rs_, 48); } while (0)
            PT_START(2);
            const int nel = 1024 * nb32;
            float mu[2], sg[2];
            { float s1 = ssum, s2 = ssq;
              s1 = PG8_DPP_ADD(s1, 0xB1); s1 = PG8_DPP_ADD(s1, 0x4E); s1 = PG8_DPP_ADD(s1, 0x141); s1 = PG8_DPP_ADD(s1, 0x140);
              s2 = PG8_DPP_ADD(s2, 0xB1); s2 = PG8_DPP_ADD(s2, 0x4E); s2 = PG8_DPP_ADD(s2, 0x141); s2 = PG8_DPP_ADD(s2, 0x140);
#pragma unroll
              for (int q = 0; q < 2; ++q) { const float nq = (float)(t0 + 2 * wid + 1 + q);
                  const float a1 = __builtin_bit_cast(float, __builtin_amdgcn_readlane(__builtin_bit_cast(int, s1), 32 * q)) + __builtin_bit_cast(float, __builtin_amdgcn_readlane(__builtin_bit_cast(int, s1), 32 * q + 16));
                  const float a2 = __builtin_bit_cast(float, __builtin_amdgcn_readlane(__builtin_bit_cast(int, s2), 32 * q)) + __builtin_bit_cast(float, __builtin_amdgcn_readlane(__builtin_bit_cast(int, s2), 32 * q + 16));
                  mu[q] = a1 / nq; sg[q] = sqrtf(fmaxf(a2 / nq - mu[q] * mu[q], 1e-12f)); } }
            const float zprev = upar ? zA1 : zA0;
            int lo[2] = {(int)0x80000001, (int)0x80000001}, hi_k[2] = {0x7FFFFFFF, 0x7FFFFFFF}, probe[2]; unsigned step[2];
#pragma unroll
            for (int q = 0; q < 2; ++q) { const float pv_ = mu[q] + zprev * sg[q], pw_ = pv_ + 0.04f * sg[q];
                int k0 = __float_as_int(pv_ + 0.f), k1 = __float_as_int(pw_ + 0.f); k0 ^= (k0 >> 31) & 0x7FFFFFFF; k1 ^= (k1 >> 31) & 0x7FFFFFFF;
                probe[q] = k0; const unsigned st_ = (unsigned)(k1 - k0); step[q] = st_ < 256u ? 256u : (st_ > (1u << 24) ? (1u << 24) : st_); }
            int clo[2] = {t0 + 2 * wid + 1, t0 + 2 * wid + 2}, chi[2] = {0, 0}; bool hl[2] = {false, false}, hh[2] = {false, false}, dn[2] = {false, false};
#pragma unroll 1
            for (int it = 0; it < 96; ++it) {
                int gg[2];
#pragma unroll
                for (int q = 0; q < 2; ++q) { const unsigned wdt = (unsigned)hi_k[q] - (unsigned)lo[q];
                    dn[q] = dn[q] || (clo[q] - chi[q] <= 32) || (wdt <= 1u);
                    int g_ = (hl[q] && hh[q]) ? (int)((unsigned)lo[q] + (wdt >> 1)) : probe[q];
                    if (g_ <= lo[q] || g_ >= hi_k[q]) g_ = (int)((unsigned)lo[q] + (wdt >> 1));
                    gg[q] = dn[q] ? lo[q] : g_; }
                if (dn[0] && dn[1]) break;
#ifdef ITER_PROBE
                if (lane == 0) atomicAdd(itcnt, 1u);
#endif
                const int gv = half ? gg[1] : gg[0];
                int cl2[2]; IDX_COUNT_LT(gv, cl2[0], cl2[1]);
#pragma unroll
                for (int q = 0; q < 2; ++q) if (!dn[q]) { const int cn = nel - cl2[q];
                    if (cn >= 256) { lo[q] = gg[q]; clo[q] = cn; hl[q] = true; const long long p_ = (long long)gg[q] + (long long)step[q]; probe[q] = p_ > 0x7FFFFFFELL ? 0x7FFFFFFE : (int)p_; }
                    else { hi_k[q] = gg[q]; chi[q] = cn; hh[q] = true; const long long p_ = (long long)gg[q] - (long long)step[q]; probe[q] = p_ < -0x7FFFFFFELL ? -0x7FFFFFFE : (int)p_; }
                    step[q] <<= 1; if (step[q] == 0u) step[q] = 1u << 31;
                    if (it == 0) {
                        const float zz = fmaxf(zprev, 0.5f), dv0 = sg[q] * __logf(fmaxf((float)cn, 0.5f) * (1.0f / 256.0f)) / (zz + 1.0f / zz) * 1.25f;
                        const float dv = (cn >= 256) ? fmaxf(dv0, 0.01f * sg[q]) : fminf(dv0, -0.01f * sg[q]);
                        int k2 = __float_as_int((mu[q] + zprev * sg[q]) + dv + 0.f); k2 ^= (k2 >> 31) & 0x7FFFFFFF; probe[q] = k2;
                        const unsigned d_ = (unsigned)(k2 > gg[q] ? k2 - gg[q] : gg[q] - k2); step[q] = d_ < 256u ? 256u : d_; } }
            }
            PT_STOP(2); PT_START(3);
            const int lov = half ? lo[1] : lo[0], hiv = half ? hi_k[1] : hi_k[0];
            const bool tieA = ((unsigned)hi_k[0] - (unsigned)lo[0] <= 1u), tieB = ((unsigned)hi_k[1] - (unsigned)lo[1] <= 1u);
            int baseA = 0, baseB = 0;
#pragma unroll
            for (int bq = 0; bq < 4; ++bq) if (bq < nb32) {
#pragma unroll
                for (int jq = 0; jq < 32; jq += 4) {
                    bool mt[4]; bool any4 = false;
#pragma unroll
                    for (int k = 0; k < 4; ++k) { const int xv = (int)x[32 * bq + jq + k]; mt[k] = (xv >= lov) && (xv < hiv); any4 = any4 || mt[k]; }
                    if (__ballot(any4)) {
#pragma unroll
                        for (int k = 0; k < 4; ++k) { const unsigned long long bm = __ballot(mt[k]); const unsigned bl = (unsigned)bm, bh = (unsigned)(bm >> 32);
                            const int pos = half ? baseB + (int)__builtin_amdgcn_mbcnt_hi(bh, 0u) : baseA + (int)__builtin_amdgcn_mbcnt_lo(bl, 0u);
                            if (mt[k] && pos < 32) candl[half * 32 + pos] = x[32 * bq + jq + k];
                            baseA += __builtin_popcount(bl); baseB += __builtin_popcount(bh); } }
                    asm volatile("" : "+s"(baseA), "+s"(baseB) :: "memory"); }
            }
            const int mcA = tieA ? 0 : clo[0] - chi[0], mcB = tieB ? 0 : clo[1] - chi[1], mcv = half ? mcB : mcA, mcmax = mcA > mcB ? mcA : mcB;
            const int needv = 256 - (half ? chi[1] : chi[0]);
            const int my = (l31 < mcv) ? (int)candl[half * 32 + l31] : (int)0x80000000;
            int cge = 0;
            LDS_WAIT();
#pragma unroll 4
            for (int j = 0; j < mcmax; ++j) { const int cj = (j < mcv) ? (int)candl[half * 32 + j] : (int)0x80000000; cge += (cj >= my) ? 1 : 0; }
            const bool okc = (l31 < mcv) && (cge >= needv);
            int vsel[2], cgt[2], neqA, neqB;
            { int vm = okc ? my : (int)0x80000000;
              vm = max(vm, __builtin_amdgcn_update_dpp((int)0x80000000, vm, 0xB1, 0xF, 0xF, false)); vm = max(vm, __builtin_amdgcn_update_dpp((int)0x80000000, vm, 0x4E, 0xF, 0xF, false));
              vm = max(vm, __builtin_amdgcn_update_dpp((int)0x80000000, vm, 0x141, 0xF, 0xF, false)); vm = max(vm, __builtin_amdgcn_update_dpp((int)0x80000000, vm, 0x140, 0xF, 0xF, false));
              { auto t_ = __builtin_amdgcn_permlane16_swap((unsigned)vm, (unsigned)vm, false, false); vm = max((int)t_[0], (int)t_[1]); }
              const int bA = __builtin_amdgcn_readlane(vm, 0), bB = __builtin_amdgcn_readlane(vm, 32);
              vsel[0] = tieA ? lo[0] : bA; vsel[1] = tieB ? lo[1] : bB;
              const int vv_ = half ? vsel[1] : vsel[0];
              const unsigned long long gtm = __ballot((l31 < mcv) && (my > vv_)), eqm = __ballot((l31 < mcv) && (my == vv_));
              cgt[0] = chi[0] + (tieA ? 0 : __builtin_popcount((unsigned)gtm)); cgt[1] = chi[1] + (tieB ? 0 : __builtin_popcount((unsigned)(gtm >> 32)));
              neqA = tieA ? clo[0] - chi[0] : __builtin_popcount((unsigned)eqm); neqB = tieB ? clo[1] - chi[1] : __builtin_popcount((unsigned)(eqm >> 32)); }
            PT_STOP(3); PT_START(4);
            { int kb_ = vsel[0]; kb_ ^= (kb_ >> 31) & 0x7FFFFFFF; const float tv_ = __int_as_float(kb_), zn_ = (tv_ - mu[0]) / sg[0]; if (upar) zA1 = zn_; else zA0 = zn_; }
            const int vv = half ? vsel[1] : vsel[0];
            const int ntkA = 256 - cgt[0], ntkB = 256 - cgt[1];
#define IDX_PUT(MM, R) do { const unsigned ml_ = (unsigned)(MM), mh_ = (unsigned)((MM) >> 32); \
                if (((R) & 1) == 0) asm volatile("s_nop 1\n\tv_writelane_b32 %0, %2, %4\n\tv_writelane_b32 %1, %3, %4" : "+v"(mAlo), "+v"(mBlo) : "s"(ml_), "s"(mh_), "i"((R) >> 1)); \
                else                asm volatile("s_nop 1\n\tv_writelane_b32 %0, %2, %4\n\tv_writelane_b32 %1, %3, %4" : "+v"(mAhi), "+v"(mBhi) : "s"(ml_), "s"(mh_), "i"((R) >> 1)); } while (0)
            if (neqA == ntkA && neqB == ntkB) {
#pragma unroll
                for (int bq = 0; bq < 4; ++bq) if (bq < nb32) {
#pragma unroll
                    for (int jq = 0; jq < 32; ++jq) { const unsigned long long mm = __ballot((int)x[32 * bq + jq] >= vv); IDX_PUT(mm, 32 * bq + jq); }
                }
            } else {
                int takenA = 0, takenB = 0; const int ntkv = half ? ntkB : ntkA;
#pragma unroll
                for (int bq = 0; bq < 4; ++bq) if (bq < nb32) {
#pragma unroll
                    for (int jq = 0; jq < 32; ++jq) { const int r = 32 * bq + jq; const bool eq = ((int)x[r] == vv), gt = ((int)x[r] > vv);
                        const unsigned long long eqm = __ballot(eq); const unsigned el = (unsigned)eqm, eh = (unsigned)(eqm >> 32);
                        const int rank = half ? takenB + (int)__builtin_amdgcn_mbcnt_hi(eh, 0u) : takenA + (int)__builtin_amdgcn_mbcnt_lo(el, 0u);
                        const unsigned long long mm = __ballot(gt || (eq && rank < ntkv)); IDX_PUT(mm, r);
                        takenA += __builtin_popcount(el); takenB += __builtin_popcount(eh);
                        asm volatile("" : "+s"(takenA), "+s"(takenB)); }
                }
            }
            PT_STOP(4);
#undef IDX_PUT
#undef IDX_COUNT_LT
        }
        PT_START(5);
#ifdef ICACHE_PROBE
        { unsigned dd_ = mAlo; asm volatile(".rept 8000\n\tv_add_u32 %0, 1, %0\n\t.endr" : "+v"(dd_)); if (dd_ == 0x12345u) mAlo ^= 1u; }
#endif
        mstage[lane * 16 + 2 * wid] = mask_perm(mAlo, mAhi); mstage[lane * 16 + 2 * wid + 1] = mask_perm(mBlo, mBhi);
        __syncthreads();
#pragma unroll
        for (int k = 0; k < 2; ++k) { const int e = F.tid + 512 * k; maskw[((size_t)b * 64 + (e >> 4)) * SEQ + t0 + (e & 15)] = mstage[e]; }
        __syncthreads();
        PT_STOP(5);
    }
}

#ifdef ITER_PROBE
#define ITERP 1
#else
#define ITERP 0
#endif
#ifdef REPBAR
#define BAR2X(B) xcd_barrier(B);
#else
#define BAR2X(B)
#endif
#ifndef MK_SPLIT
#define MK_SPLIT 0
#endif
constexpr int N_PHASES = 25;

__global__ void __launch_bounds__(NWAVES * 64, 2) fwd_kernel(Ptrs Pin) {
    typedef const __attribute__((address_space(4))) Ptrs* KargPtr;
    extern __shared__ __attribute__((aligned(16))) unsigned char lds_raw[];
    Frame F;
    F.lds = (LAS unsigned char*)lds_raw;
    volatile LAS unsigned* MISC = (volatile LAS unsigned*)(F.lds + MISC_OFF);
    F.tid = threadIdx.x; F.lane = F.tid & 63; F.wave = __builtin_amdgcn_readfirstlane(F.tid >> 6);
    F.bid = blockIdx.x; F.G = gridDim.x; { const int bx = blockIdx.x; F.vcu = (F.G % 8 == 0) ? (bx % 8) * (F.G / 8) + bx / 8 : bx; }
    for (int u = F.tid; u < (LDS_BYTES - LDSCTL_OFF) / 4; u += NWAVES * 64) ((LAS unsigned*)(F.lds + LDSCTL_OFF))[u] = 0u;
    __syncthreads();
    unsigned* ctl = (unsigned*)(Pin.ws + WS_CTL);
    if (!MK_SPLIT) (void)xcd_barrier_post(ctl + CW_BAR, MISC + 8);
    const int lo = Pin.ph_lo, hi = Pin.ph_hi; (void)lo; (void)hi;
    int ph = 0;
    unsigned long long pt_acc = 0ull, pt_t0 = 0ull; (void)pt_acc; (void)pt_t0;
#if MK_SPLIT
#define PH_COND (lo <= ph && ph < hi)
#else
#define PH_COND true
#endif
#define PH_BEGIN if (PH_COND) { asm volatile("" : "+s"(F.wave), "+s"(F.vcu), "+s"(F.G), "+s"(F.bid)); F.lane = (int)__builtin_amdgcn_mbcnt_hi(~0u, __builtin_amdgcn_mbcnt_lo(~0u, 0u)); asm volatile("" : "+v"(F.lane)); F.tid = F.wave * 64 + F.lane; KargPtr pk_ = (KargPtr)__builtin_amdgcn_kernarg_segment_ptr(); asm volatile("" : "+s"(pk_)); PT_START(100 + ph); PT_START(200 + ph);
#define PH_END   PT_STOP(200 + ph); if (!MK_SPLIT && (ph + 1 < N_PHASES || PROBE_T || ITERP)) { unsigned char* wsx_ = P.ws; XcdBarrier b2_; b2_.bar = (unsigned*)(wsx_ + WS_CTL) + CW_BAR; b2_.x = xb_xcc_id(); b2_.st = MISC + 8; b2_.t0 = (F.tid == 0); xcd_barrier(b2_); BAR2X(b2_) } PT_STOP(100 + ph); } ++ph;

#define P (*pk_)
#define H ((bf16*)(P.ws + WS_H))
#define QBUF ((bf16*)(P.ws + WS_Q))
#define KVB ((unsigned char*)(P.ws + WS_KV))
#define WI32 ((float*)(P.ws + WS_WI))
#define ACT ((bf16*)(P.ws + WS_KV))
#define OB ((bf16*)(P.ws + WS_H))
#define MASKW ((unsigned long long*)(P.ws + WS_MASK))
#define wl (P.ws + WS_W + (size_t)l * LAYER_W_BYTES)
#define modl ((const float*)(P.ws + WS_MOD) + (size_t)l * NB * NMODC)
#define XB ((bf16*)(P.ws + WS_XB))

#ifdef REPP
    PH_BEGIN p0_prologue(F, pk_); __syncthreads(); p0_prologue(F, pk_); PH_END
#else
    PH_BEGIN p0_prologue(F, pk_); PH_END
#endif

#pragma unroll 1
    for (int l = 0; l < 2; ++l) {
        PH_BEGIN if (l == 0) norm_mod_phase<true, false>(F, P.x, P.norm_ffn1 + l * DM, modl, 0, 1, H); else norm_mod_phase<true, true>(F, XB, P.norm_ffn1 + l * DM, modl, 0, 1, H); PH_END
        PH_BEGIN { pg8::Gemm g{H, (const bf16*)(wl + OFF_WGU1), MTOK, NGU, DM / 2}; pg8::StaticOrder S; S.init(MTOK, NGU, F.G, F.bid);
                   pg8::EpiSwiGLU<true> E{ACT, DFF}; pg8::gemm_phase<pg8::EpiSwiGLU<true>, pg8::StaticOrder, true, true, true>(F.lds, g, S, E, F.wave); } PH_END
        PH_BEGIN { pg8::Gemm g{ACT, (const bf16*)(wl + OFF_WD1), MTOK, DM, DFF / 2}; pg8::StaticOrder S; S.init(MTOK, DM, F.G, F.bid);
                   if (l == 0) { pg8::EpiResid<false, true> E{P.x, XB, modl, 2, 0.5f}; pg8::gemm_phase<pg8::EpiResid<false, true>, pg8::StaticOrder, true, true, true>(F.lds, g, S, E, F.wave); }
                   else { pg8::EpiResid<true, true> E{XB, XB, modl, 2, 0.5f}; pg8::gemm_phase<pg8::EpiResid<true, true>, pg8::StaticOrder, true, true, true>(F.lds, g, S, E, F.wave); } } PH_END
        PH_BEGIN norm_mod_phase<false, true>(F, XB, P.norm_mix + l * DM, modl, 3, 4, H); PH_END
        PH_BEGIN { pg8::Gemm g{H, (const bf16*)(wl + OFF_WIN), MTOK, NPROJ, DM}; pg8::StaticOrder S; S.init(MTOK, NPROJ, F.G, F.bid);
                   pg8::EpiProj E{QBUF, KVB, WI32, P.qn_a + l * 64, P.kn_a + l * 64, P.qn_c + l * 64, P.kn_c + l * 64, QSCALE};
                   pg8::gemm_phase<pg8::EpiProj, pg8::StaticOrder, true, true>(F.lds, g, S, E, F.wave); } PH_END
        PH_BEGIN {
            idx_phase(F, QBUF, KVB, WI32, MASKW, pt_acc, pt_t0);
            PT_START(13);
            unsigned* qctr = (unsigned*)(P.ws + WS_CTL) + 3072 + 64 * l;
            volatile LAS unsigned* qslot = MISC + 16;
            for (;;) {
                __syncthreads();
                if (F.tid == 0) *qslot = __hip_atomic_fetch_add(qctr, 1u, __ATOMIC_RELAXED, __HIP_MEMORY_SCOPE_AGENT);
                __syncthreads();
                const unsigned item = *qslot;
                if (item >= 1024u) break;
                if (item < 512u) { const int u = (int)item, bh = u >> 3, h = bh & 7; const int idx = 3 * (h >> 1) + (h & 1);
                    PT_START(14);
#ifdef REPC
                    att::attC_unit(bh >> 3, h, u & 7, QBUF, KVB, OB, F.lds, exp2f(-(2.0f / 3.0f) * (float)(idx + 1)) * LOG2E, F.wave); __syncthreads();
#endif
                    att::attC_unit(bh >> 3, h, u & 7, QBUF, KVB, OB, F.lds, exp2f(-(2.0f / 3.0f) * (float)(idx + 1)) * LOG2E, F.wave); if (pt_acc == 0) PT_STOP(14); }
                else { const int u = (int)item - 512, bh = u >> 4; PT_START(15);
#ifdef REPB
                    att::attB_unit(bh >> 2, bh & 3, u & 15, QBUF, KVB, OB, F.lds, F.wave); __syncthreads();
#endif
                    att::attB_unit(bh >> 2, bh & 3, u & 15, QBUF, KVB, OB, F.lds, F.wave); if (pt_acc == 0) PT_STOP(15); }
            }
            PT_STOP(13);
        } PH_END
        PH_BEGIN {
            PT_START(11);
            for (int p = F.vcu; p < 256; p += F.G) { const int bh = p >> 3, b = bh >> 2, h = bh & 3, s = p & 7; const float slope2 = exp2f(-(float)(2 * h + 2)) * LOG2E;
                att::attA_unit_s(b, h, s, QBUF, KVB, MASKW, OB, F.lds, slope2, F.wave); att::attA_unit_s(b, h, 15 - s, QBUF, KVB, MASKW, OB, F.lds, slope2, F.wave); }
            PT_STOP(11);
        } PH_END
        PH_BEGIN group_norm_phase(F, OB, (unsigned char*)QBUF); PH_END
        PH_BEGIN { pg8::Gemm g{(const bf16*)QBUF, (const bf16*)(wl + OFF_WOUT), MTOK, DM, DM / 2}; pg8::StaticOrder S; S.init(MTOK, DM, F.G, F.bid);
                   pg8::EpiResid<true, true> E{XB, XB, modl, 5, 1.0f}; pg8::gemm_phase<pg8::EpiResid<true, true>, pg8::StaticOrder, true, true, true>(F.lds, g, S, E, F.wave); } PH_END
        PH_BEGIN norm_mod_phase<true, true>(F, XB, P.norm_ffn2 + l * DM, modl, 6, 7, H); PH_END
        PH_BEGIN { pg8::Gemm g{H, (const bf16*)(wl + OFF_WGU2), MTOK, NGU, DM / 2}; pg8::StaticOrder S; S.init(MTOK, NGU, F.G, F.bid);
                   pg8::EpiSwiGLU<true> E{ACT, DFF}; pg8::gemm_phase<pg8::EpiSwiGLU<true>, pg8::StaticOrder, true, true, true>(F.lds, g, S, E, F.wave); } PH_END
        PH_BEGIN { pg8::Gemm g{ACT, (const bf16*)(wl + OFF_WD2), MTOK, DM, DFF / 2}; pg8::StaticOrder S; S.init(MTOK, DM, F.G, F.bid);
                   if (l == 1) { pg8::EpiResid<true, false> E{XB, P.out, modl, 8, 0.5f}; pg8::gemm_phase<pg8::EpiResid<true, false>, pg8::StaticOrder, true, true, true>(F.lds, g, S, E, F.wave); }
                   else { pg8::EpiResid<true, true> E{XB, XB, modl, 8, 0.5f}; pg8::gemm_phase<pg8::EpiResid<true, true>, pg8::StaticOrder, true, true, true>(F.lds, g, S, E, F.wave); } } PH_END
    }
#if PROBE_T || defined(ITER_PROBE)
    {   KargPtr pk_ = (KargPtr)__builtin_amdgcn_kernarg_segment_ptr(); asm volatile("" : "+s"(pk_));
        unsigned* ctlp = (unsigned*)(P.ws + WS_CTL);
        if (F.bid == PROBE_BLK && F.tid == 0) __hip_atomic_store(ctlp + 2048, (unsigned)(pt_acc >> 4), __ATOMIC_RELAXED, __HIP_MEMORY_SCOPE_AGENT);
        { XcdBarrier b2_; b2_.bar = ctlp + CW_BAR; b2_.x = xb_xcc_id(); b2_.st = MISC + 8; b2_.t0 = (F.tid == 0); xcd_barrier(b2_); }
#ifdef ITER_PROBE
        const float sc = 1.0f + (float)__hip_atomic_load(ctlp + 2064, __ATOMIC_RELAXED, __HIP_MEMORY_SCOPE_AGENT) / (2.0f * 8.0f * 240.0f * 8.0f);
#else
        const float cyc = 16.0f * (float)__hip_atomic_load(ctlp + 2048, __ATOMIC_RELAXED, __HIP_MEMORY_SCOPE_AGENT);
        const float sc = 1.0f + 10.0f * ((rintf(4.0f * log2f(fmaxf(cyc, 1024.0f)) + PROBE_SHIFT) - PROBE_SHIFT) * 0.25f - 10.0f);
#endif
        for (size_t i = (size_t)F.bid * NWAVES * 64 + F.tid; i < (size_t)MTOK * DM; i += (size_t)F.G * NWAVES * 64) P.out[i] *= sc;
    }
#endif
#undef PH_BEGIN
#undef PH_END
#undef P
#undef H
#undef QBUF
#undef KVB
#undef WI32
#undef ACT
#undef OB
#undef MASKW
#undef wl
#undef modl
#undef XB
}

extern "C" void kernel_launch(void* const* d_in, const int* in_sizes, int n_in, void* d_out, int out_size, void* d_ws, size_t ws_size, hipStream_t stream) {
    static int grid = 0;
    if (grid == 0) {
        if (n_in != 20 || in_sizes[0] != MTOK * DM || out_size != MTOK * DM || ws_size < WS_END) { fprintf(stderr, "kernel_launch: unexpected shapes (n_in %d, in0 %d, out %d, ws %zu); nothing launched\n", n_in, n_in > 0 ? in_sizes[0] : -1, out_size, ws_size); grid = -1; return; }
        int dev = 0, cus = 0, per_cu = 0;
        if (hipGetDevice(&dev) != hipSuccess || hipDeviceGetAttribute(&cus, hipDeviceAttributeMultiprocessorCount, dev) != hipSuccess) { grid = -1; return; }
        if (hipFuncSetAttribute((const void*)fwd_kernel, hipFuncAttributeMaxDynamicSharedMemorySize, LDS_BYTES) != hipSuccess) { fprintf(stderr, "kernel_launch: hipFuncSetAttribute failed\n"); grid = -1; return; }
        if (hipOccupancyMaxActiveBlocksPerMultiprocessor(&per_cu, (const void*)fwd_kernel, NWAVES * 64, LDS_BYTES) != hipSuccess || per_cu < 1)
            fprintf(stderr, "kernel_launch: note: occupancy query reports %d workgroups per CU\n", per_cu);
        (void)hipGetLastError();
        grid = cus;
    }
    if (grid < 0) return;
    if (hipMemsetAsync((char*)d_ws + WS_CTL, 0, CTL_ZERO_BYTES, stream) != hipSuccess) return;
    Ptrs a{};
    const float** pp = (const float**)&a;
    for (int i = 0; i < 20; ++i) pp[i] = (const float*)d_in[i];
    a.out = (float*)d_out; a.ws = (unsigned char*)d_ws;
#if MK_SPLIT
    for (int k = 0; k < N_PHASES; ++k) { a.ph_lo = k; a.ph_hi = k + 1; hipLaunchKernelGGL(fwd_kernel, dim3(grid), dim3(NWAVES * 64), LDS_BYTES, stream, a); }
#else
    a.ph_lo = 0; a.ph_hi = N_PHASES;
    hipLaunchKernelGGL(fwd_kernel, dim3(grid), dim3(NWAVES * 64), LDS_BYTES, stream, a);
#endif
    const hipError_t le = hipPeekAtLastError();
    if (le != hipSuccess) fprintf(stderr, "kernel_launch: launch failed: %s\n", hipGetErrorName(le));
}
```

```cpp
#include <hip/hip_runtime.h>
#include <cstdio>
#include <cstdint>
namespace pg8 {
#define PG8_LAS __attribute__((address_space(3)))
typedef unsigned short bf16_t;
typedef short bf16x8 __attribute__((ext_vector_type(8)));
typedef float f32x4 __attribute__((ext_vector_type(4)));
typedef unsigned u32x4 __attribute__((ext_vector_type(4)));
constexpr int BM = 256, BK = 64, HALF = 128, HTB = HALF * BK * 2  , STAGE_BYTES = 8 * HTB, NXCD = 8, WGM = 8;

__host__ __device__ __forceinline__ int lds_byte(int r, int c) { const int st = (r >> 4) * 2 + (c >> 5), rr = r & 15, cc = c & 31, ob = rr * 64 + cc * 2; return st * 1024 + (ob ^ (((ob >> 9) & 1) << 5)); }
__host__ __device__ __forceinline__ void stage_rc(int b, int& R, int& C) { const int st = b / 1024, sb = b % 1024, swz = sb ^ (((sb >> 9) & 1) << 5); R = (st >> 1) * 16 + swz / 64; C = (st & 1) * 32 + (swz % 64) / 2; }
__host__ __device__ __forceinline__ int perm32(int rho) { const int n = rho >> 4, i = rho & 15; return 8 * (i >> 2) + 4 * n + (i & 3); }

struct Unit { int pm, pn; };
struct Gemm { const bf16_t* A; const bf16_t* Bt; int M, N, K; };

struct StaticOrder {
    int nM, nN, nwg, G, c;
    __host__ __device__ void init(int M, int N, int G_, int c_) { nM = M / BM; nN = N / BM; nwg = nM * nN; G = G_; c = c_; }
    __host__ __device__ bool next(int i, Unit& u) const {
        const long L = (long)i * G + c; if (L >= nwg) return false;
        int wgid = (int)L; { const int q = nwg / NXCD, r = nwg % NXCD, xcd = wgid % NXCD, off = wgid / NXCD; wgid = (xcd < r ? xcd * (q + 1) : r * (q + 1) + (xcd - r) * q) + off; }
        const int nig = WGM * nN, gid = wgid / nig, fm = gid * WGM, gsz = (nM - fm) < WGM ? (nM - fm) : WGM;
        u.pm = fm + ((wgid % nig) % gsz); u.pn = (wgid % nig) / gsz; return true;
    }
    __device__ __forceinline__ void a_ready(const Unit&) const {}
    __device__ __forceinline__ void done(const Unit&) const {}
};

typedef float f32x2 __attribute__((ext_vector_type(2)));
typedef __bf16 bf16x2_t __attribute__((ext_vector_type(2)));
__device__ __forceinline__ unsigned cvt_pk_bf16(float lo, float hi) { f32x2 v = {lo, hi}; bf16x2_t b = __builtin_convertvector(v, bf16x2_t); return __builtin_bit_cast(unsigned, b); }

__device__ __forceinline__ float xsum16(float v) { auto t = __builtin_amdgcn_permlane16_swap(__float_as_uint(v), __float_as_uint(v), false, false); return __uint_as_float(t[0]) + __uint_as_float(t[1]); }
__device__ __forceinline__ float xsum32(float v) { auto t = __builtin_amdgcn_permlane32_swap(__float_as_uint(v), __float_as_uint(v), false, false); return __uint_as_float(t[0]) + __uint_as_float(t[1]); }
#define PG8_DPP_ADD(v, ctrl) ((v) + __uint_as_float((unsigned)__builtin_amdgcn_update_dpp(0, (int)__float_as_uint(v), ctrl, 0xF, 0xF, true)))
__device__ __forceinline__ float wave_sum_f(float v) {
    v = PG8_DPP_ADD(v, 0xB1); v = PG8_DPP_ADD(v, 0x4E); v = PG8_DPP_ADD(v, 0x141); v = PG8_DPP_ADD(v, 0x140);
    return xsum32(xsum16(v));
}
__device__ __forceinline__ unsigned pk4_fp8(float a, float b, float c, float d) {
    a = __builtin_amdgcn_fmed3f(a, -448.f, 448.f); b = __builtin_amdgcn_fmed3f(b, -448.f, 448.f); c = __builtin_amdgcn_fmed3f(c, -448.f, 448.f); d = __builtin_amdgcn_fmed3f(d, -448.f, 448.f);
    int w = __builtin_amdgcn_cvt_pk_fp8_f32(a, b, 0, false); w = __builtin_amdgcn_cvt_pk_fp8_f32(c, d, w, true); return (unsigned)w; }
template <bool F8OUT> struct EpiSwiGLU {
    static constexpr bool PERM = true, AFTER_DRAIN = false;
    bf16_t* O; int ldc;
    __device__ __forceinline__ void operator()(const f32x4 (&acc)[2][2][4][2], const Unit& u, int wr, int wc, int fr, int fq) const {
        const int row0 = u.pm * BM + wr * 64 + fr, col0 = u.pn * HALF + wc * 32 + 8 * fq;
#pragma unroll
        for (int ai = 0; ai < 2; ++ai)
#pragma unroll
            for (int m = 0; m < 4; ++m) {
                float v[8];
#pragma unroll
                for (int n = 0; n < 2; ++n)
#pragma unroll
                    for (int j = 0; j < 4; j += 2) {
                        typedef float f32x2_ __attribute__((ext_vector_type(2)));
                        const f32x2_ g = {acc[ai][0][m][n][j], acc[ai][0][m][n][j + 1]}, up = {acc[ai][1][m][n][j], acc[ai][1][m][n][j + 1]};
                        const f32x2_ t = g * (f32x2_){-1.4426950408889634f, -1.4426950408889634f};
                        f32x2_ d = {__builtin_amdgcn_exp2f(t.x), __builtin_amdgcn_exp2f(t.y)}; d = d + (f32x2_){1.0f, 1.0f};
                        const f32x2_ r = {__builtin_amdgcn_rcpf(d.x), __builtin_amdgcn_rcpf(d.y)};
                        const f32x2_ o2 = (g * r) * up;
                        v[n * 4 + j] = o2.x; v[n * 4 + j + 1] = o2.y; }
                if constexpr (F8OUT) { typedef unsigned u32x2_ __attribute__((ext_vector_type(2))); unsigned char* rowp = (unsigned char*)O + (size_t)(row0 + ai * HALF + m * 16) * ldc + col0;
                    u32x2_ w; w.x = pk4_fp8(v[0], v[1], v[2], v[3]); w.y = pk4_fp8(v[4], v[5], v[6], v[7]); *(u32x2_*)rowp = w; }
                else { bf16_t* rowp = O + (size_t)(row0 + ai * HALF + m * 16) * ldc + col0;
                    u32x4 w; w.x = cvt_pk_bf16(v[0], v[1]); w.y = cvt_pk_bf16(v[2], v[3]); w.z = cvt_pk_bf16(v[4], v[5]); w.w = cvt_pk_bf16(v[6], v[7]);
                    *(u32x4*)rowp = w; }
            }
    }
};

template <bool BASE_BF16, bool OUT_BF16> struct EpiResid {
    static constexpr bool PERM = true, AFTER_DRAIN = false;
    const void* base; void* out; const float* modl; int chunk; float coef;
    __device__ __forceinline__ void operator()(const f32x4 (&acc)[2][2][4][2], const Unit& u, int wr, int wc, int fr, int fq) const {
        const int row0 = u.pm * BM + wr * 64 + fr, col0 = u.pn * BM + wc * 32 + 8 * fq;
        const float* gate = modl + (size_t)(u.pm >> 4) * 9216 + chunk * 1024;
        f32x4 gv[2][2];
#pragma unroll
        for (int bj = 0; bj < 2; ++bj)
#pragma unroll
            for (int n = 0; n < 2; ++n) gv[bj][n] = *(const f32x4*)(gate + col0 + bj * HALF + 4 * n) * coef;
        if constexpr (BASE_BF16) {
#pragma unroll
            for (int ai = 0; ai < 2; ++ai) { u32x4 wb[4][2];
#pragma unroll
                for (int m = 0; m < 4; ++m)
#pragma unroll
                    for (int bj = 0; bj < 2; ++bj) wb[m][bj] = *(const u32x4*)((const bf16_t*)base + (size_t)(row0 + ai * HALF + m * 16) * 1024 + col0 + bj * HALF);
                asm volatile("" ::: "memory");
#pragma unroll
                for (int m = 0; m < 4; ++m)
#pragma unroll
                    for (int bj = 0; bj < 2; ++bj) { const size_t o = (size_t)(row0 + ai * HALF + m * 16) * 1024 + col0 + bj * HALF; const u32x4 w = wb[m][bj];
                        const f32x4 b0 = (f32x4){__uint_as_float(w.x << 16), __uint_as_float(w.x & 0xffff0000u), __uint_as_float(w.y << 16), __uint_as_float(w.y & 0xffff0000u)};
                        const f32x4 b1 = (f32x4){__uint_as_float(w.z << 16), __uint_as_float(w.z & 0xffff0000u), __uint_as_float(w.w << 16), __uint_as_float(w.w & 0xffff0000u)};
                        const f32x4 r0 = b0 + gv[bj][0] * acc[ai][bj][m][0], r1 = b1 + gv[bj][1] * acc[ai][bj][m][1];
                        if constexpr (OUT_BF16) { u32x4 wo; wo.x = cvt_pk_bf16(r0[0], r0[1]); wo.y = cvt_pk_bf16(r0[2], r0[3]); wo.z = cvt_pk_bf16(r1[0], r1[1]); wo.w = cvt_pk_bf16(r1[2], r1[3]); *(u32x4*)((bf16_t*)out + o) = wo; }
                        else { *(f32x4*)((float*)out + o) = r0; *(f32x4*)((float*)out + o + 4) = r1; } }
                asm volatile("" ::: "memory"); }
            return; }
#pragma unroll
        for (int ai = 0; ai < 2; ++ai)
#pragma unroll
            for (int m = 0; m < 4; ++m) { const size_t off = (size_t)(row0 + ai * HALF + m * 16) * 1024 + col0;
#pragma unroll
                for (int bj = 0; bj < 2; ++bj) { const size_t o = off + bj * HALF; f32x4 b0, b1;
                    if constexpr (BASE_BF16) { const u32x4 w = *(const u32x4*)((const bf16_t*)base + o);
                        b0 = (f32x4){__uint_as_float(w.x << 16), __uint_as_float(w.x & 0xffff0000u), __uint_as_float(w.y << 16), __uint_as_float(w.y & 0xffff0000u)};
                        b1 = (f32x4){__uint_as_float(w.z << 16), __uint_as_float(w.z & 0xffff0000u), __uint_as_float(w.w << 16), __uint_as_float(w.w & 0xffff0000u)}; }
                    else { b0 = *(const f32x4*)((const float*)base + o); b1 = *(const f32x4*)((const float*)base + o + 4); }
                    const f32x4 r0 = b0 + gv[bj][0] * acc[ai][bj][m][0], r1 = b1 + gv[bj][1] * acc[ai][bj][m][1];
                    if constexpr (OUT_BF16) { u32x4 w; w.x = cvt_pk_bf16(r0[0], r0[1]); w.y = cvt_pk_bf16(r0[2], r0[3]); w.z = cvt_pk_bf16(r1[0], r1[1]); w.w = cvt_pk_bf16(r1[2], r1[3]); *(u32x4*)((bf16_t*)out + o) = w; }
                    else { *(f32x4*)((float*)out + o) = r0; *(f32x4*)((float*)out + o + 4) = r1; } }
                if (m & 1) asm volatile("" ::: "memory"); }
    }
};

struct EpiProj {
    static constexpr bool PERM = true, AFTER_DRAIN = false;
    static constexpr size_t HB = 4096 * 128;
    bf16_t* QB; unsigned char* KV; float* WI; const float *qn_a, *kn_a, *qn_c, *kn_c; float qscale;
    static constexpr size_t KT_A = 0, KT_B = 32 * HB, KT_C = 64 * HB, KT_I = 256 * HB, VT_A = 264 * HB, VT_B = 296 * HB, VT_C = 328 * HB, KV_BYTES = 392 * HB, DSTRIDE = 64 * HB;
    __device__ __forceinline__ void operator()(const f32x4 (&acc)[2][2][4][2], const Unit& u, int wr, int wc, int fr, int fq) const {
        const int pn = u.pn;
        if (pn == 14 && wc >= 2) return;
        const float* gain = pn == 0 ? qn_a : pn == 1 ? kn_a : (pn == 6 || pn == 7) ? qn_c : (pn == 8 || pn == 9) ? kn_c : nullptr;
        const float sc = (pn == 0 || pn == 3 || pn == 6 || pn == 7) ? qscale : 1.0f;
        const int row0 = u.pm * BM + wr * 64 + fr, b = u.pm >> 4, t0 = (u.pm & 15) * BM + wr * 64 + fr;
        f32x4 gv[2][2];
#pragma unroll
        for (int bj = 0; bj < 2; ++bj)
#pragma unroll
            for (int n = 0; n < 2; ++n) gv[bj][n] = gain ? *(const f32x4*)(gain + 32 * bj + 8 * fq + 4 * n) * sc : (f32x4){sc, sc, sc, sc};
        int kind, nd = 1; size_t base = 0; int qcol = 0;
        if (pn == 0) { kind = 0; qcol = 0; } else if (pn == 3) { kind = 0; qcol = 256; } else if (pn == 6 || pn == 7) { kind = 0; qcol = 512 + 256 * (pn - 6); } else if (pn == 12 || pn == 13) { kind = 0; qcol = 1024 + 256 * (pn - 12); }
        else if (pn == 1) { kind = 1; base = KT_A + (size_t)(b * 4 + wc) * HB; } else if (pn == 4) { kind = 1; base = KT_B + (size_t)(b * 4 + wc) * HB; }
        else if (pn == 8 || pn == 9) { kind = 1; nd = 3; base = KT_C + (size_t)(b * 8 + 4 * (pn - 8) + wc) * HB; }
        else if (pn == 2) { kind = 2; base = VT_A + (size_t)(b * 4 + wc) * HB; } else if (pn == 5) { kind = 2; base = VT_B + (size_t)(b * 4 + wc) * HB; }
        else if (pn == 10 || pn == 11) { kind = 2; base = VT_C + (size_t)(b * 8 + 4 * (pn - 10) + wc) * HB; }
        else { if (wc == 0) { kind = 1; base = KT_I + (size_t)b * HB; } else kind = 3; }
#pragma unroll
        for (int ai = 0; ai < 2; ++ai)
#pragma unroll
            for (int m = 0; m < 4; ++m) {
                float rs = 1.0f;
                if (gain) { float ss = 0.f;
#pragma unroll
                    for (int bj = 0; bj < 2; ++bj)
#pragma unroll
                        for (int n = 0; n < 2; ++n) { const f32x4 x = acc[ai][bj][m][n]; ss += (x[0] * x[0] + x[1] * x[1]) + (x[2] * x[2] + x[3] * x[3]); }
                    ss = xsum32(xsum16(ss));
                    rs = __builtin_amdgcn_rsqf(ss * (1.0f / 64.0f) + 1e-6f); }
                const int t = t0 + ai * HALF + m * 16;
                if (kind == 3) { if (fq == 0) { float* wp = WI + (size_t)(row0 + ai * HALF + m * 16) * 8; *(f32x4*)wp = acc[ai][0][m][0]; *(f32x4*)(wp + 4) = acc[ai][0][m][1]; } continue; }
#pragma unroll
                for (int bj = 0; bj < 2; ++bj) { const f32x4 v0 = acc[ai][bj][m][0] * gv[bj][0] * rs, v1 = acc[ai][bj][m][1] * gv[bj][1] * rs;
                    u32x4 w; w.x = cvt_pk_bf16(v0[0], v0[1]); w.y = cvt_pk_bf16(v0[2], v0[3]); w.z = cvt_pk_bf16(v1[0], v1[1]); w.w = cvt_pk_bf16(v1[2], v1[3]);
                    if (kind == 0) *(u32x4*)(QB + (size_t)(row0 + ai * HALF + m * 16) * 1536 + qcol + wc * 64 + 32 * bj + 8 * fq) = w;
                    else {
                        for (int d = 0; d < nd; ++d) { const int sh = 2 * d, p = ((t & ((1 << sh) - 1)) << (12 - sh)) + (t >> sh);
                            unsigned char* dst = KV + base + (size_t)d * DSTRIDE;
                            if (kind == 1) dst += (size_t)(((p >> 5) * 8 + 4 * bj + fq) * 512 + (p & 31) * 16);
                            else dst += (size_t)(((p >> 4) * 2 + bj) * 1024 + (p & 15) * 64 + fq * 16);
                            *(u32x4*)dst = w; } }
                }
            }
    }
};

template <class Epi, class Sched, bool ALIGN_EPI = false, bool SP2 = false, bool FP8 = false>
__device__ __forceinline__ void gemm_phase(PG8_LAS unsigned char* lds, const Gemm g, const Sched& S, const Epi& E, int wave_id) {
    int tid_o = wave_id * 64 + (int)__builtin_amdgcn_mbcnt_hi(~0u, __builtin_amdgcn_mbcnt_lo(~0u, 0u)); asm volatile("" : "+v"(tid_o));
    const int tid = tid_o, wid = __builtin_amdgcn_readfirstlane(tid >> 6), lane = tid & 63, wr = wid >> 2, wc = wid & 3, fr = lane & 15, fq = lane >> 4;
    const int K = g.K, nt = K / BK;
    unsigned voffA[2], voffB[2];
#pragma unroll
    for (int i = 0; i < 2; ++i) { int R, C; stage_rc(tid * 16 + i * 8192, R, C); const int Rb = Epi::PERM ? ((R & ~31) + perm32(R & 31)) : R;
        voffA[i] = (unsigned)(R * K + C) * 2u; voffB[i] = (unsigned)(Rb * K + C) * 2u; }
    const size_t kstep = (size_t)(BK * 2);
    const size_t hstep = (size_t)HALF * K * 2;
    const size_t tstep = 2 * hstep;
    const unsigned ldsw = (unsigned)wid * 1024u;
    const int aoff = lds_byte(wr * 64 + fr, fq * 8), boff = lds_byte(wc * 32 + fr, fq * 8);
#define PG8_SA(b, h) (((b) * 2 + (h)) * HTB)
#define PG8_SB(b, h) ((4 + (b) * 2 + (h)) * HTB)
#define PG8_STAGE(bufoff, gbase, voff) do { _Pragma("unroll") for (int _i = 0; _i < 2; ++_i) \
        __builtin_amdgcn_global_load_lds((const unsigned*)((const char*)(gbase) + (voff)[_i]), (PG8_LAS unsigned*)(lds + (bufoff) + ldsw + _i * 8192), 16, 0, 0); } while (0)
#define PG8_LDA(dst, b, h) do { _Pragma("unroll") for (int m = 0; m < 4; ++m) { \
        if constexpr (FP8) { dst##8[m].lo = *(const PG8_LAS i32x4_*)(lds + PG8_SA(b, h) + aoff + m * 2048); dst##8[m].hi = *(const PG8_LAS i32x4_*)(lds + PG8_SA(b, h) + aoff + m * 2048 + 1024); } \
        else { _Pragma("unroll") for (int k = 0; k < 2; ++k) dst[m][k] = *(const PG8_LAS bf16x8*)(lds + PG8_SA(b, h) + aoff + m * 2048 + k * 1024); } } } while (0)
#define PG8_LDB(dst, b, h) do { _Pragma("unroll") for (int n = 0; n < 2; ++n) { \
        if constexpr (FP8) { dst##8[n].lo = *(const PG8_LAS i32x4_*)(lds + PG8_SB(b, h) + boff + n * 2048); dst##8[n].hi = *(const PG8_LAS i32x4_*)(lds + PG8_SB(b, h) + boff + n * 2048 + 1024); } \
        else { _Pragma("unroll") for (int k = 0; k < 2; ++k) dst[n][k] = *(const PG8_LAS bf16x8*)(lds + PG8_SB(b, h) + boff + n * 2048 + k * 1024); } } } while (0)
#define PG8_MMA(ai, bj, At, Bt) do { __builtin_amdgcn_s_setprio(1); _Pragma("unroll") for (int m = 0; m < 4; ++m) _Pragma("unroll") for (int n = 0; n < 2; ++n) { \
          \
        if constexpr (FP8) asm volatile("v_mfma_scale_f32_16x16x128_f8f6f4 %0, %1, %2, %0, %3, %4 op_sel_hi:[0,0,0]" : "+v"(acc[ai][bj][m][n]) : "v"(Bt##8[n]), "v"(At##8[m]), "v"(scale_w_), "v"(scale_a_));   \
        else { _Pragma("unroll") for (int k = 0; k < 2; ++k) acc[ai][bj][m][n] = __builtin_amdgcn_mfma_f32_16x16x32_bf16(Bt[n][k], At[m][k], acc[ai][bj][m][n], 0, 0, 0); } } \
        __builtin_amdgcn_s_setprio(0); } while (0)
#define PG8_WAIT_V(n) asm volatile("s_waitcnt vmcnt(" #n ")" ::: "memory")
#define PG8_WAIT_L(n) asm volatile("s_waitcnt lgkmcnt(" #n ")" ::: "memory")
#define PG8_BAR __builtin_amdgcn_s_barrier()
#define PG8_SCHED __builtin_amdgcn_sched_barrier(0)
    Unit cur, nxt; int ui = 0;
    if (!S.next(0, cur)) return;
    f32x4 acc[2][2][4][2];
#pragma unroll
    for (int a = 0; a < 2; ++a)
#pragma unroll
        for (int b = 0; b < 2; ++b)
#pragma unroll
            for (int m = 0; m < 4; ++m)
#pragma unroll
                for (int n = 0; n < 2; ++n) acc[a][b][m][n] = (f32x4){0.f, 0.f, 0.f, 0.f};
    typedef int i32x8_ __attribute__((ext_vector_type(8))); typedef int i32x4_ __attribute__((ext_vector_type(4)));
    const int scale_w_ = 122, scale_a_ = 127;
    bf16x8 At[4][2], B0[2][2], B1[2][2]; i32x8_ At8[4], B08[2], B18[2];
    const char* cA = (const char*)g.A + (size_t)cur.pm * tstep; const char* cB = (const char*)g.Bt + (size_t)cur.pn * tstep;
    S.a_ready(cur);
    if constexpr (SP2) {
        PG8_STAGE(PG8_SB(0, 0), cB, voffB); PG8_STAGE(PG8_SB(0, 1), cB + hstep, voffB); PG8_STAGE(PG8_SA(0, 0), cA, voffA); PG8_STAGE(PG8_SA(0, 1), cA + hstep, voffA);
        if (wr == 1) PG8_BAR;
        PG8_WAIT_V(2); PG8_BAR;
        PG8_STAGE(PG8_SB(1, 0), cB + kstep, voffB); PG8_STAGE(PG8_SA(1, 0), cA + kstep, voffA); PG8_STAGE(PG8_SB(1, 1), cB + hstep + kstep, voffB);
        PG8_WAIT_V(6); PG8_BAR;
    } else {
        PG8_STAGE(PG8_SB(0, 0), cB, voffB); PG8_STAGE(PG8_SA(0, 0), cA, voffA); PG8_STAGE(PG8_SB(0, 1), cB + hstep, voffB); PG8_STAGE(PG8_SA(0, 1), cA + hstep, voffA);
        if (wr == 1) PG8_BAR;
        PG8_WAIT_V(4); PG8_BAR;
        PG8_STAGE(PG8_SB(1, 0), cB + kstep, voffB); PG8_STAGE(PG8_SA(1, 0), cA + kstep, voffA); PG8_STAGE(PG8_SB(1, 1), cB + hstep + kstep, voffB);
        PG8_WAIT_V(6); PG8_BAR;
    }
    for (;;) {
        const bool has_next = S.next(ui + 1, nxt);
        const char* nA = has_next ? (const char*)g.A + (size_t)nxt.pm * tstep : cA; const char* nB = has_next ? (const char*)g.Bt + (size_t)nxt.pn * tstep : cB;
        _Pragma("unroll 1") for (int t = 0; t < nt; t += 2) {
            const bool last = (t == nt - 2);
            const char* a1 = cA + (size_t)(t + 1) * kstep;
            const char* a2 = last ? nA : cA + (size_t)(t + 2) * kstep; const char* b2 = last ? nB : cB + (size_t)(t + 2) * kstep;
            const char* a3 = a2 + kstep; const char* b3 = b2 + kstep;
            if (last && has_next) S.a_ready(nxt);
            if constexpr (SP2) {
            PG8_LDB(B0, 0, 0); PG8_LDB(B1, 0, 1); PG8_SCHED; PG8_LDA(At, 0, 0); PG8_STAGE(PG8_SA(1, 1), a1 + hstep, voffA);
            PG8_WAIT_V(8); PG8_WAIT_L(0); PG8_BAR; PG8_MMA(0, 0, At, B0); PG8_MMA(0, 1, At, B1); PG8_BAR; PG8_SCHED;
            PG8_LDA(At, 0, 1); PG8_STAGE(PG8_SB(0, 0), b2, voffB); PG8_STAGE(PG8_SB(0, 1), b2 + hstep, voffB); PG8_STAGE(PG8_SA(0, 0), a2, voffA);
            PG8_WAIT_V(8); PG8_WAIT_L(0); PG8_BAR; PG8_MMA(1, 0, At, B0); PG8_MMA(1, 1, At, B1); PG8_BAR; PG8_SCHED;
            PG8_LDB(B0, 1, 0); PG8_LDB(B1, 1, 1); PG8_SCHED; PG8_LDA(At, 1, 0); PG8_STAGE(PG8_SA(0, 1), a2 + hstep, voffA);
            PG8_WAIT_V(8); PG8_WAIT_L(0); PG8_BAR; PG8_MMA(0, 0, At, B0); PG8_MMA(0, 1, At, B1); PG8_BAR; PG8_SCHED;
            PG8_LDA(At, 1, 1); PG8_STAGE(PG8_SB(1, 0), b3, voffB); PG8_STAGE(PG8_SB(1, 1), b3 + hstep, voffB); PG8_STAGE(PG8_SA(1, 0), a3, voffA);
            PG8_WAIT_V(8); PG8_WAIT_L(0); PG8_BAR; PG8_MMA(1, 0, At, B0); PG8_MMA(1, 1, At, B1); PG8_BAR; PG8_SCHED;
            } else {
            PG8_LDB(B0, 0, 0); PG8_SCHED; PG8_LDA(At, 0, 0); PG8_STAGE(PG8_SA(1, 1), a1 + hstep, voffA);
            PG8_WAIT_L(8); PG8_BAR; PG8_WAIT_L(0); PG8_MMA(0, 0, At, B0); PG8_BAR; PG8_SCHED;
            PG8_LDB(B1, 0, 1); PG8_STAGE(PG8_SB(0, 0), b2, voffB);
            PG8_BAR; PG8_WAIT_L(0); PG8_MMA(0, 1, At, B1); PG8_BAR;
            PG8_LDA(At, 0, 1); PG8_STAGE(PG8_SA(0, 0), a2, voffA);
            PG8_BAR; PG8_WAIT_L(0); PG8_MMA(1, 0, At, B0); PG8_BAR; PG8_SCHED;
            PG8_STAGE(PG8_SB(0, 1), b2 + hstep, voffB);
            PG8_WAIT_V(6); PG8_BAR; PG8_MMA(1, 1, At, B1); PG8_BAR;
            PG8_LDB(B0, 1, 0); PG8_SCHED; PG8_LDA(At, 1, 0); PG8_STAGE(PG8_SA(0, 1), a2 + hstep, voffA);
            PG8_WAIT_L(8); PG8_BAR; PG8_WAIT_L(0); PG8_MMA(0, 0, At, B0); PG8_BAR; PG8_SCHED;
            PG8_LDB(B1, 1, 1); PG8_STAGE(PG8_SB(1, 0), b3, voffB);
            PG8_BAR; PG8_WAIT_L(0); PG8_MMA(0, 1, At, B1); PG8_BAR;
            PG8_LDA(At, 1, 1); PG8_STAGE(PG8_SA(1, 0), a3, voffA);
            PG8_BAR; PG8_WAIT_L(0); PG8_MMA(1, 0, At, B0); PG8_BAR; PG8_SCHED;
            PG8_STAGE(PG8_SB(1, 1), b3 + hstep, voffB);
            PG8_WAIT_V(6); PG8_BAR; PG8_MMA(1, 1, At, B1); PG8_BAR;
            }
        }
        if constexpr (FP8) asm volatile("s_nop 15\n\ts_nop 15" ::: "memory");
        if constexpr (ALIGN_EPI) { if (wr == 0) PG8_BAR; }
        if constexpr (!Epi::AFTER_DRAIN) { E(acc, cur, wr, wc, fr, fq); S.done(cur); }
        if (!has_next) break;
#pragma unroll
        for (int a = 0; a < 2; ++a)
#pragma unroll
            for (int b = 0; b < 2; ++b)
#pragma unroll
                for (int m = 0; m < 4; ++m)
#pragma unroll
                    for (int n = 0; n < 2; ++n) acc[a][b][m][n] = (f32x4){0.f, 0.f, 0.f, 0.f};
        cur = nxt; cA = nA; cB = nB; ++ui;
        if constexpr (ALIGN_EPI) { if (wr == 1) PG8_BAR; }
    }
    PG8_WAIT_V(0);
    if constexpr (!ALIGN_EPI) { if (wr == 0) PG8_BAR; }
    PG8_BAR;
    if constexpr (Epi::AFTER_DRAIN) { E.fused(acc, cur, wr, wc, fr, fq, lds, wid, lane); S.done(cur); }
#undef PG8_SA
#undef PG8_SB
#undef PG8_STAGE
#undef PG8_LDA
#undef PG8_LDB
#undef PG8_MMA
#undef PG8_WAIT_V
#undef PG8_WAIT_L
#undef PG8_BAR
#undef PG8_SCHED
}
}

constexpr int NB = 8, SEQ = 4096, DM = 1024, MTOK = NB * SEQ, DFF = 2816, NGU = 2 * DFF, NPROJ = 3840, NMODC = 9 * DM, WIN_COLS = 3656;
constexpr float LOG2E = 1.4426950408889634f, QSCALE = 0.125f * 1.4426950408889634f;
constexpr int NWAVES = 8;

constexpr size_t MiB = 1u << 20;
constexpr size_t WS_CTL = 0, CTL_ZERO_BYTES = 1 * MiB;
constexpr size_t WS_MOD = 2 * MiB;
constexpr size_t WS_W = 4 * MiB;
constexpr size_t OFF_WGU1 = 0, OFF_WD1 = OFF_WGU1 + (size_t)NGU * DM, OFF_WGU2 = OFF_WD1 + (size_t)DM * DFF, OFF_WD2 = OFF_WGU2 + (size_t)NGU * DM,
                 OFF_WIN = OFF_WD2 + (size_t)DM * DFF, OFF_WOUT = OFF_WIN + (size_t)NPROJ * DM * 2, LAYER_W_BYTES = OFF_WOUT + (size_t)DM * DM * 2;
constexpr size_t WS_WI = 3 * MiB;
constexpr size_t WS_H = 64 * MiB;
constexpr size_t WS_Q = 128 * MiB;
constexpr size_t WS_KV = 224 * MiB;
constexpr size_t WS_XB = 420 * MiB;
constexpr size_t WS_MASK = 484 * MiB;
constexpr size_t WS_END = 500 * MiB;
constexpr int QPITCH = 1536, QC_A = 0, QC_B = 256, QC_C = 512, QC_I = 1024;
static_assert(WS_W + 2 * LAYER_W_BYTES <= WS_H && WS_H + (size_t)MTOK * DM * 2 <= WS_Q && WS_Q + (size_t)MTOK * QPITCH * 2 <= WS_KV && WS_KV + pg8::EpiProj::KV_BYTES <= WS_XB && WS_XB + (size_t)MTOK * DM * 2 <= WS_MASK && WS_MASK + (size_t)NB * 64 * SEQ * 8 <= WS_END, "d_ws map");
constexpr int CW_BAR = 4096;
constexpr int RING_BYTES = 131072, EXTRA_OFF = RING_BYTES, LDSCTL_OFF = EXTRA_OFF + 4096, MISC_OFF = LDSCTL_OFF + 320, LDS_BYTES = 147456;

#define GAS __attribute__((address_space(1)))
#define LAS __attribute__((address_space(3)))
typedef unsigned short bf16;
typedef unsigned v4u __attribute__((ext_vector_type(4)));
typedef unsigned v2u __attribute__((ext_vector_type(2)));
typedef float f32x4 __attribute__((ext_vector_type(4)));
typedef short bf16x8 __attribute__((ext_vector_type(8)));
typedef GAS unsigned gu32;
#define LDS_WAIT() asm volatile("s_waitcnt lgkmcnt(0)" ::: "memory")
#define VM_WAIT() asm volatile("s_waitcnt vmcnt(0)" ::: "memory")
__device__ __forceinline__ unsigned pk2(float lo, float hi) { return pg8::cvt_pk_bf16(lo, hi); }
__device__ __forceinline__ float bf2f(bf16 v) { return __uint_as_float((unsigned)v << 16); }

#ifndef PROBE_T
#define PROBE_T 0
#endif
#ifndef PROBE_SHIFT
#define PROBE_SHIFT 0.0f
#endif
#ifndef PROBE_BLK
#define PROBE_BLK 128
#endif
#if PROBE_T
#define PT_START(k) do { if ((k) == PROBE_T) pt_t0 = __builtin_amdgcn_s_memtime(); } while (0)
#define PT_STOP(k)  do { if ((k) == PROBE_T) pt_acc += __builtin_amdgcn_s_memtime() - pt_t0; } while (0)
#else
#define PT_START(k) do {} while (0)
#define PT_STOP(k) do {} while (0)
#endif
#define XB_TMO      128
#define XB_XCNT(j)  (256  + 64 * (j))
#define XB_XSUB(j)  (1280 + 64 * (j))
#define XB_XGEN(j)  (2304 + 64 * (j))
#define XB_TOP      3328
#define XB_TOPGEN   3392
#define XCD_BAR_WORDS 3456
#define XB_SPIN_CAP (1u << 18)

__device__ __forceinline__ unsigned xb_ld(unsigned* p)              { return __hip_atomic_load(p, __ATOMIC_RELAXED, __HIP_MEMORY_SCOPE_AGENT); }
__device__ __forceinline__ unsigned xb_add(unsigned* p, unsigned v) { return __hip_atomic_fetch_add(p, v, __ATOMIC_RELAXED, __HIP_MEMORY_SCOPE_AGENT); }
__device__ __forceinline__ unsigned xb_xcc_id() { return (unsigned)__builtin_amdgcn_s_getreg((3 << 11) | 20) & 0xFu; }
#define XB_SPIN(cond, bar) do { unsigned _sp = 0; while (cond) { __builtin_amdgcn_s_sleep(1); \
    if ((++_sp & 255u) == 0u) { if (xb_ld(&(bar)[XB_TMO])) break; if (_sp > XB_SPIN_CAP) { atomicAdd(&(bar)[XB_TMO], 1u); break; } } } } while (0)

struct XcdBarrier {
    bool t0;
    unsigned* bar; unsigned x;
    volatile LAS unsigned* st;
};

__device__ __forceinline__ XcdBarrier xcd_barrier_post(unsigned* bar, volatile LAS unsigned* st) {
    XcdBarrier b; b.bar = bar; b.x = xb_xcc_id(); b.st = st; b.t0 = (threadIdx.x == 0);
    if (threadIdx.x == 0) (void)xb_add(&bar[XB_XCNT(b.x)], 1u);
    return b;
}
__device__ __forceinline__ void xcd_barrier_complete(unsigned* bar, unsigned x, unsigned& nloc, unsigned& nx) {
    const unsigned G = gridDim.x * gridDim.y * gridDim.z;
    unsigned sum, cnt, mine, sp = 0u;
    for (;;) {
        sum = 0u; cnt = 0u; mine = 0u;
#pragma unroll
        for (unsigned j = 0; j < 16; ++j) { const unsigned c = xb_ld(&bar[XB_XCNT(j)]); sum += c; cnt += (c > 0u) ? 1u : 0u; mine = (j == x) ? c : mine; }
        if (sum == G) break;
        __builtin_amdgcn_s_sleep(1);
        if ((++sp & 255u) == 0u) { if (xb_ld(&bar[XB_TMO])) break; if (sp > XB_SPIN_CAP) { atomicAdd(&bar[XB_TMO], 1u); break; } }
    }
    nloc = mine > 0u ? mine : 1u; nx = cnt > 0u ? cnt : 1u;
}

__device__ __forceinline__ void xcd_barrier(const XcdBarrier& b) {
    asm volatile("s_waitcnt vmcnt(0)" ::: "memory");
    __syncthreads();
    if (b.t0) {
        unsigned* bar = b.bar;
        __builtin_amdgcn_s_waitcnt(0);
        unsigned nloc = b.st[0], nx = b.st[1];
        if (nloc == 0u) { xcd_barrier_complete(bar, b.x, nloc, nx); b.st[0] = nloc; b.st[1] = nx; }
        const unsigned old = xb_add(&bar[XB_XSUB(b.x)], 1u);
        const unsigned gen = old / nloc;
        if (old + 1u == (gen + 1u) * nloc) {
            __builtin_amdgcn_fence(__ATOMIC_RELEASE, "agent");
            asm volatile("s_waitcnt vmcnt(0)" ::: "memory");
            const unsigned og = xb_add(&bar[XB_TOP], 1u);
            const unsigned tg = og / nx;
            if (og + 1u == (tg + 1u) * nx) xb_add(&bar[XB_TOPGEN], 1u);
            else XB_SPIN(xb_ld(&bar[XB_TOPGEN]) == tg, bar);
            __builtin_amdgcn_fence(__ATOMIC_ACQUIRE, "agent");
            xb_add(&bar[XB_XGEN(b.x)], 1u);
            asm volatile("s_waitcnt vmcnt(0)" ::: "memory");
        } else {
            XB_SPIN(xb_ld(&bar[XB_XGEN(b.x)]) == gen, bar);
            __builtin_amdgcn_fence(__ATOMIC_ACQUIRE, "agent");
            asm volatile("s_waitcnt vmcnt(0)" ::: "memory");
        }
    }
    __syncthreads();
}

struct Frame {
    LAS unsigned char* lds;
    int tid, lane, wave;
    int vcu, G, bid;
};
__device__ __forceinline__ float wave_sum(float v) { return pg8::wave_sum_f(v); }

template <bool F8>
__device__ __forceinline__ void transpose_item(const float* W, int ldw, int c0, int ncols, int K, int kb, void* WTv, int dst_row0, const float* kscale, LAS float* scr, int lane) {
    const int k0 = 64 * kb, n = lane & 31;
#pragma unroll 8
    for (int i = 0; i < 32; ++i) { const int kk = 2 * i + (lane >> 5);
        float v = 0.f;
        if (n < ncols) { v = __builtin_nontemporal_load(W + (size_t)(k0 + kk) * ldw + c0 + n); if (kscale) v *= kscale[k0 + kk]; }
        scr[kk * 33 + n] = v; }
    LDS_WAIT(); asm volatile("" ::: "memory");
    const int c = lane & 7;
#pragma unroll
    for (int j = 0; j < 4; ++j) { const int nn = (lane >> 3) + 8 * j; const LAS float* s = scr + (8 * c) * 33 + nn;
        if constexpr (F8) {
            v2u o; o.x = pg8::pk4_fp8(32.f * s[0 * 33], 32.f * s[1 * 33], 32.f * s[2 * 33], 32.f * s[3 * 33]); o.y = pg8::pk4_fp8(32.f * s[4 * 33], 32.f * s[5 * 33], 32.f * s[6 * 33], 32.f * s[7 * 33]);
            *(GAS v2u*)((unsigned char*)WTv + (size_t)(dst_row0 + nn) * K + k0 + 8 * c) = o;
        } else { bf16* WT = (bf16*)WTv;
            v4u o; o.x = pk2(s[0 * 33], s[1 * 33]); o.y = pk2(s[2 * 33], s[3 * 33]); o.z = pk2(s[4 * 33], s[5 * 33]); o.w = pk2(s[6 * 33], s[7 * 33]);
            *(GAS v4u*)(WT + (size_t)(dst_row0 + nn) * K + k0 + 8 * c) = o; } }
    LDS_WAIT(); asm volatile("" ::: "memory");
}
__device__ __forceinline__ void transpose_quad(const float* W, int ldw, int c0, int K, int kb, unsigned char* WT, int dst_row0, const float* kscale, LAS float* scr, int lane) {
    typedef float f32x4_ __attribute__((ext_vector_type(4)));
    const int k0 = 64 * kb, n4 = 4 * (lane & 31), kr = lane >> 5;
    f32x4_ v[32];
#pragma unroll
    for (int i = 0; i < 32; ++i) v[i] = *(const GAS f32x4_*)(W + (size_t)(k0 + 2 * i + kr) * ldw + c0 + n4);
    if (kscale) {
#pragma unroll
        for (int i = 0; i < 32; ++i) v[i] = v[i] * kscale[k0 + 2 * i + kr]; }
    const int c = lane & 7;
#pragma unroll
    for (int q = 0; q < 4; ++q) {
        if (((lane & 31) >> 3) == q) {
#pragma unroll
            for (int i = 0; i < 32; ++i) *(LAS f32x4_*)(scr + (2 * i + kr) * 36 + (n4 & 31)) = v[i]; }
        LDS_WAIT(); asm volatile("" ::: "memory");
#pragma unroll
        for (int j = 0; j < 4; ++j) { const int nn = (lane >> 3) + 8 * j; const LAS float* sp = scr + (8 * c) * 36 + nn;
            v2u o; o.x = pg8::pk4_fp8(32.f * sp[0 * 36], 32.f * sp[1 * 36], 32.f * sp[2 * 36], 32.f * sp[3 * 36]); o.y = pg8::pk4_fp8(32.f * sp[4 * 36], 32.f * sp[5 * 36], 32.f * sp[6 * 36], 32.f * sp[7 * 36]);
            *(GAS v2u*)(WT + (size_t)(dst_row0 + 32 * q + nn) * K + k0 + 8 * c) = o; }
        LDS_WAIT(); asm volatile("" ::: "memory");
    }
}
struct Ptrs {
    const float *x, *c, *w_ada, *b_ada, *norm_ffn1, *w_gate1, *w_up1, *w_down1, *norm_mix, *w_in, *qn_a, *kn_a, *qn_c, *kn_c, *g_out, *w_out, *norm_ffn2, *w_gate2, *w_up2, *w_down2;
    float* out; unsigned char* ws; int ph_lo, ph_hi;
};
constexpr int IT_GU = (NGU / 128) * (DM / 64), IT_D = (DM / 128) * (DFF / 64), IT_IN = (NPROJ / 32) * (DM / 64), IT_OUT = (DM / 128) * (DM / 64);
constexpr int IT_LAYER = 2 * IT_GU + 2 * IT_D + IT_IN + IT_OUT;
template <class KP>
__device__ __forceinline__ void p0_prologue(Frame& F, KP P) {
    {
        LAS float* sl = (LAS float*)F.lds;
        LAS float* part = (LAS float*)(F.lds + 32768);
        float* mod = (float*)(P->ws + WS_MOD);
        if (F.bid < 288) {
            for (int i = F.tid; i < NB * DM; i += NWAVES * 64) { const float cv = P->c[i]; sl[i] = cv / (1.0f + __expf(-cv)); }
            __syncthreads(); }
        for (int it = F.bid; it < 288; it += F.G) {
            const int l = it / 144, cb = it % 144, rsub = F.lane >> 4, c4 = 4 * (F.lane & 15);
            f32x4 acc[NB];
#pragma unroll
            for (int b = 0; b < NB; ++b) acc[b] = (f32x4){0.f, 0.f, 0.f, 0.f};
            const float* wp = P->w_ada + (size_t)l * DM * NMODC + 64 * cb + c4;
#pragma unroll 8
            for (int kk = 0; kk < 32; ++kk) { const int k = 128 * F.wave + 4 * kk + rsub; const f32x4 wv = __builtin_nontemporal_load((const GAS f32x4*)(wp + (size_t)k * NMODC));
#pragma unroll
                for (int b = 0; b < NB; ++b) acc[b] += wv * sl[b * DM + k]; }
#pragma unroll
            for (int b = 0; b < NB; ++b) { f32x4 t = acc[b];
                t.x = pg8::xsum32(pg8::xsum16(t.x)); t.y = pg8::xsum32(pg8::xsum16(t.y)); t.z = pg8::xsum32(pg8::xsum16(t.z)); t.w = pg8::xsum32(pg8::xsum16(t.w));
                if (rsub == 0) *(LAS f32x4*)(part + (F.wave * NB + b) * 64 + c4) = t; }
            __syncthreads();
            { const int o = F.tid, b = o >> 6, col = o & 63; float sum = P->b_ada[l * NMODC + 64 * cb + col];
#pragma unroll
              for (int w = 0; w < NWAVES; ++w) sum += part[(w * NB + b) * 64 + col];
              mod[(size_t)(l * NB + b) * NMODC + 64 * cb + col] = sum; }
            __syncthreads();
        }
    }
    LAS float* scr = (LAS float*)(F.lds + F.wave * 16384);
    const int gw = F.vcu * NWAVES + F.wave, NGW = F.G * NWAVES;
    for (int it0 = gw; it0 < 2 * IT_LAYER; it0 += NGW) {
        const int l = it0 / IT_LAYER; int it = it0 % IT_LAYER;
        unsigned char* wl = P->ws + WS_W + (size_t)l * LAYER_W_BYTES;
        if (it < 2 * (IT_GU + IT_D)) {
            const int f2 = it >= (IT_GU + IT_D); if (f2) it -= IT_GU + IT_D;
            const float* wg = (f2 ? P->w_gate2 : P->w_gate1) + (size_t)l * DM * DFF; const float* wu = (f2 ? P->w_up2 : P->w_up1) + (size_t)l * DM * DFF;
            const float* wd = (f2 ? P->w_down2 : P->w_down1) + (size_t)l * DFF * DM;
            if (it < IT_GU) { const int gq = it / (DM / 64), kb = it % (DM / 64), pn = gq >> 1;
                transpose_quad((gq & 1) ? wu : wg, DFF, 128 * pn, DM, kb, wl + (f2 ? OFF_WGU2 : OFF_WGU1), 128 * gq, nullptr, scr, F.lane); }
            else { it -= IT_GU; const int gq = it / (DFF / 64), kb = it % (DFF / 64);
                transpose_quad(wd, DM, 128 * gq, DFF, kb, wl + (f2 ? OFF_WD2 : OFF_WD1), 128 * gq, nullptr, scr, F.lane); }
            continue;
        }
        it -= 2 * (IT_GU + IT_D);
        if (it < IT_IN) { const int g = it / (DM / 64), kb = it % (DM / 64), pn = g >> 3, sub = g & 7, bj = sub >> 2, wc = sub & 3, pc0 = 256 * pn + 64 * wc + 32 * bj;
            int c0 = 0, nc = 32;
            if (pc0 < 768) c0 = pc0; else if (pc0 < 1536) c0 = pc0 - 768 + 1352; else if (pc0 < 3072) c0 = pc0 - 1536 + 2120; else if (pc0 < 3584) c0 = pc0 - 3072 + 768;
            else if (pc0 < 3648) c0 = pc0 - 3584 + 1280; else if (pc0 == 3648) { c0 = 1344; nc = 8; } else nc = 0;
            transpose_item<false>(P->w_in + (size_t)l * DM * WIN_COLS, WIN_COLS, c0, nc, DM, kb, wl + OFF_WIN, 32 * g, nullptr, scr, F.lane);
            continue; }
        it -= IT_IN;
        { const int gq = it / (DM / 64), kb = it % (DM / 64);
          transpose_quad(P->w_out + (size_t)l * DM * DM, DM, 128 * gq, DM, kb, wl + OFF_WOUT, 128 * gq, P->g_out + l * DM, scr, F.lane); }
    }
}

template <bool F8OUT, bool IN_BF16>
__device__ __forceinline__ void norm_mod_phase(Frame& F, const void* xsrc, const float* gain, const float* modl, int ch_shift, int ch_scale, void* houtv) {
    for (int rb = F.bid; rb < MTOK / 128; rb += F.G) {
        const int b = rb >> 5;
        const float* shp = modl + (size_t)b * NMODC + ch_shift * DM; const float* scp = modl + (size_t)b * NMODC + ch_scale * DM;
        f32x4 ga[4], sh[4];
#pragma unroll
        for (int j = 0; j < 4; ++j) { const int col = 4 * F.lane + 256 * j; const f32x4 g = *(const GAS f32x4*)(gain + col), s = *(const GAS f32x4*)(scp + col);
            ga[j] = g * (s + 1.0f); sh[j] = *(const GAS f32x4*)(shp + col); }
#pragma unroll 1
        for (int r0 = 0; r0 < 16; r0 += 4) { const int rowb = 128 * rb + 16 * F.wave + r0;
            f32x4 vv[4][4];
            if constexpr (IN_BF16) { v2u w[4][4];
#pragma unroll
                for (int k = 0; k < 4; ++k) { const GAS v2u* xr = (const GAS v2u*)((const bf16*)xsrc + (size_t)(rowb + k) * DM) + F.lane;
#pragma unroll
                    for (int j = 0; j < 4; ++j) w[k][j] = xr[64 * j]; }
#pragma unroll
                for (int k = 0; k < 4; ++k)
#pragma unroll
                    for (int j = 0; j < 4; ++j) vv[k][j] = (f32x4){__uint_as_float(w[k][j].x << 16), __uint_as_float(w[k][j].x & 0xffff0000u), __uint_as_float(w[k][j].y << 16), __uint_as_float(w[k][j].y & 0xffff0000u)}; }
            else {
#pragma unroll
                for (int k = 0; k < 4; ++k) { const GAS f32x4* xr = (const GAS f32x4*)((const float*)xsrc + (size_t)(rowb + k) * DM) + F.lane;
#pragma unroll
                    for (int j = 0; j < 4; ++j) vv[k][j] = xr[64 * j]; } }
#pragma unroll
            for (int k = 0; k < 4; ++k) { const int row = rowb + k; const f32x4 (&v)[4] = vv[k]; float ss = 0.f;
#pragma unroll
                for (int j = 0; j < 4; ++j) ss += (v[j].x * v[j].x + v[j].y * v[j].y) + (v[j].z * v[j].z + v[j].w * v[j].w);
                const float rstd = 1.0f / sqrtf(wave_sum(ss) * (1.0f / DM) + 1e-6f);
                if constexpr (F8OUT) { GAS unsigned* o4 = (GAS unsigned*)((unsigned char*)houtv + (size_t)row * DM) + F.lane;
#pragma unroll
                    for (int j = 0; j < 4; ++j) { const f32x4 y = v[j] * rstd * ga[j] + sh[j]; o4[64 * j] = pg8::pk4_fp8(y.x, y.y, y.z, y.w); } }
                else { GAS v2u* o8 = (GAS v2u*)((bf16*)houtv + (size_t)row * DM) + F.lane;
#pragma unroll
                    for (int j = 0; j < 4; ++j) { const f32x4 y = v[j] * rstd * ga[j] + sh[j]; v2u w; w.x = pk2(y.x, y.y); w.y = pk2(y.z, y.w); o8[64 * j] = w; } }
            }
        }
    }
}
__device__ __forceinline__ void group_norm_phase(Frame& F, const bf16* o, unsigned char* y8) {
    const int gw = F.bid * NWAVES + F.wave, NGW = F.G * NWAVES;
#pragma unroll 1
    for (int row0 = gw; row0 < MTOK; row0 += 4 * NGW) {
        v2u wq[4][4];
#pragma unroll
        for (int k = 0; k < 4; ++k) { const int row = row0 + k * NGW; const GAS v2u* orow = (const GAS v2u*)(o + (size_t)(row < MTOK ? row : row0) * DM) + F.lane;
#pragma unroll
            for (int j = 0; j < 4; ++j) wq[k][j] = orow[64 * j]; }
#pragma unroll
        for (int k = 0; k < 4; ++k) { const int row = row0 + k * NGW; if (row >= MTOK) break;
            float v[4][4], ss[4];
#pragma unroll
            for (int j = 0; j < 4; ++j) { const v2u w = wq[k][j]; v[j][0] = __uint_as_float(w.x << 16); v[j][1] = __uint_as_float(w.x & 0xffff0000u); v[j][2] = __uint_as_float(w.y << 16); v[j][3] = __uint_as_float(w.y & 0xffff0000u);
                ss[j] = wave_sum((v[j][0] * v[j][0] + v[j][1] * v[j][1]) + (v[j][2] * v[j][2] + v[j][3] * v[j][3])); }
            float rs[4];
            rs[0] = 1.0f / sqrtf(ss[0] * (1.0f / 256.f) + 1e-6f); rs[1] = 1.0f / sqrtf(ss[1] * (1.0f / 256.f) + 1e-6f); rs[2] = rs[3] = 1.0f / sqrtf((ss[2] + ss[3]) * (1.0f / 512.f) + 1e-6f);
            GAS unsigned* yrow = (GAS unsigned*)(y8 + (size_t)row * DM) + F.lane;
#pragma unroll
            for (int j = 0; j < 4; ++j) yrow[64 * j] = pg8::pk4_fp8(v[j][0] * rs[j], v[j][1] * rs[j], v[j][2] * rs[j], v[j][3] * rs[j]);
        }
    }
}

namespace att {
typedef float f32x16 __attribute__((ext_vector_type(16)));
typedef short s16x4 __attribute__((ext_vector_type(4)));
__device__ __forceinline__ int crow(int r, int hi) { return (r & 3) + 8 * (r >> 2) + 4 * hi; }
#define SBAR() __builtin_amdgcn_sched_barrier(0)
__device__ __forceinline__ void pv(f32x16* o, int vb, bf16x8 pa0, bf16x8 pa1, bf16x8 pa2, bf16x8 pa3) {
#pragma unroll
    for (int d0 = 0; d0 < 2; ++d0) { s16x4 lo[4], hi[4];
#pragma unroll
        for (int ks = 0; ks < 4; ++ks) {
            asm volatile("ds_read_b64_tr_b16 %0,%1 offset:%c2" : "=&v"(lo[ks]) : "v"(vb), "i"(d0 * 4096 + ks * 1024) : "memory");
            asm volatile("ds_read_b64_tr_b16 %0,%1 offset:%c2" : "=&v"(hi[ks]) : "v"(vb), "i"(d0 * 4096 + ks * 1024 + 512) : "memory"); }
        asm volatile("s_waitcnt lgkmcnt(0)" ::: "memory"); SBAR();
#define PK(k) (bf16x8){lo[k][0], lo[k][1], lo[k][2], lo[k][3], hi[k][0], hi[k][1], hi[k][2], hi[k][3]}
        __builtin_amdgcn_s_setprio(1);
        o[d0] = __builtin_amdgcn_mfma_f32_32x32x16_bf16(pa0, PK(0), o[d0], 0, 0, 0);
        o[d0] = __builtin_amdgcn_mfma_f32_32x32x16_bf16(pa1, PK(1), o[d0], 0, 0, 0);
        o[d0] = __builtin_amdgcn_mfma_f32_32x32x16_bf16(pa2, PK(2), o[d0], 0, 0, 0);
        o[d0] = __builtin_amdgcn_mfma_f32_32x32x16_bf16(pa3, PK(3), o[d0], 0, 0, 0);
        __builtin_amdgcn_s_setprio(0);
#undef PK
    }
}
__device__ __forceinline__ void qkt(f32x16& p0, f32x16& p1, const bf16x8 (&kf)[8], const bf16x8 (&qr)[4]) {
    p0 = (f32x16){}; p1 = (f32x16){};
#pragma unroll
    for (int d0 = 0; d0 < 4; ++d0) { p0 = __builtin_amdgcn_mfma_f32_32x32x16_bf16(kf[2 * d0], qr[d0], p0, 0, 0, 0); p1 = __builtin_amdgcn_mfma_f32_32x32x16_bf16(kf[2 * d0 + 1], qr[d0], p1, 0, 0, 0); }
}
__device__ __forceinline__ void load_k(bf16x8 (&kf)[8], const bf16* k0, const bf16* k1) {
#pragma unroll
    for (int d0 = 0; d0 < 4; ++d0) { kf[2 * d0] = *(const GAS bf16x8*)(k0 + 16 * d0); kf[2 * d0 + 1] = *(const GAS bf16x8*)(k1 + 16 * d0); }
}
__device__ __forceinline__ void stage_v(const bf16* v0, const bf16* v1, const bf16* v2, const bf16* v3, LAS unsigned char* slot) {
    const bf16* vg[4] = {v0, v1, v2, v3};
#pragma unroll
    for (int dh = 0; dh < 2; ++dh)
#pragma unroll
        for (int kg = 0; kg < 4; ++kg)
            __builtin_amdgcn_global_load_lds((const unsigned*)(vg[kg] + dh * 32), (LAS unsigned*)(slot + (dh * 4 + kg) * 1024), 16, 0, 0);
}
__device__ __forceinline__ float swap_max(float m) { auto rr = __builtin_amdgcn_permlane32_swap(__float_as_uint(m), __float_as_uint(m), false, false); return fmaxf(__uint_as_float(rr[0]), __uint_as_float(rr[1])); }
__device__ __forceinline__ float swap_sum(float m) { auto rr = __builtin_amdgcn_permlane32_swap(__float_as_uint(m), __float_as_uint(m), false, false); return __uint_as_float(rr[0]) + __uint_as_float(rr[1]); }
__device__ __forceinline__ float rowmax32(const f32x16& p0, const f32x16& p1) {
    float a = fmaxf(p0[0], p1[0]);
#pragma unroll
    for (int r = 1; r < 16; ++r) a = fmaxf(a, fmaxf(p0[r], p1[r]));
    return swap_max(a);
}
__device__ __forceinline__ void scale_rows(f32x16 (&o)[2], LAS float* wsf, float f, int r32, int hi) {
    if (hi == 0) wsf[r32] = f;
#pragma unroll
    for (int r = 0; r < 16; ++r) { const float fr = wsf[crow(r, hi)]; o[0][r] *= fr; o[1][r] *= fr; }
}
#define PACK4(P, B) (v4u){pk2(P[B], P[B + 1]), pk2(P[B + 2], P[B + 3]), pk2(P[B + 4], P[B + 5]), pk2(P[B + 6], P[B + 7])}
__device__ __forceinline__ void softmax_step(f32x16& p0, f32x16& p1, float& m, float& lsum, f32x16 (&o)[2], LAS float* wsf, int r32, int hi) {
    const float rm = rowmax32(p0, p1), mnew = fmaxf(m, rm);
    if (__any(mnew > m)) { const float f = __builtin_amdgcn_exp2f(m - mnew); lsum *= f; scale_rows(o, wsf, f, r32, hi); m = mnew; }
    float s = 0.f;
#pragma unroll
    for (int r = 0; r < 16; ++r) { p0[r] = __builtin_amdgcn_exp2f(p0[r] - m); p1[r] = __builtin_amdgcn_exp2f(p1[r] - m); s += p0[r] + p1[r]; }
    lsum += s;
}
__device__ __forceinline__ void softmax_step1(f32x16& p1, float& m, float& lsum, f32x16 (&o)[2], LAS float* wsf, int r32, int hi) {
    float a = p1[0];
#pragma unroll
    for (int r = 1; r < 16; ++r) a = fmaxf(a, p1[r]);
    const float rm = swap_max(a), mnew = fmaxf(m, rm);
    if (__any(mnew > m)) { const float f = __builtin_amdgcn_exp2f(m - mnew); lsum *= f; scale_rows(o, wsf, f, r32, hi); m = mnew; }
    float s = 0.f;
#pragma unroll
    for (int r = 0; r < 16; ++r) { p1[r] = __builtin_amdgcn_exp2f(p1[r] - m); s += p1[r]; }
    lsum += s;
}
__device__ __forceinline__ void pv_half(f32x16* o, int vb, bf16x8 pa2, bf16x8 pa3) {
#pragma unroll
    for (int d0 = 0; d0 < 2; ++d0) { s16x4 lo[2], hi[2];
#pragma unroll
        for (int ks = 0; ks < 2; ++ks) {
            asm volatile("ds_read_b64_tr_b16 %0,%1 offset:%c2" : "=&v"(lo[ks]) : "v"(vb), "i"(d0 * 4096 + (ks + 2) * 1024) : "memory");
            asm volatile("ds_read_b64_tr_b16 %0,%1 offset:%c2" : "=&v"(hi[ks]) : "v"(vb), "i"(d0 * 4096 + (ks + 2) * 1024 + 512) : "memory"); }
        asm volatile("s_waitcnt lgkmcnt(0)" ::: "memory"); SBAR();
#define PK(k) (bf16x8){lo[k][0], lo[k][1], lo[k][2], lo[k][3], hi[k][0], hi[k][1], hi[k][2], hi[k][3]}
        o[d0] = __builtin_amdgcn_mfma_f32_32x32x16_bf16(pa2, PK(0), o[d0], 0, 0, 0);
        o[d0] = __builtin_amdgcn_mfma_f32_32x32x16_bf16(pa3, PK(1), o[d0], 0, 0, 0);
#undef PK
    }
}
__device__ __forceinline__ void pv_tile(f32x16 (&o)[2], const f32x16& p0, const f32x16& p1, int vb) {
    const v4u w0 = PACK4(p0, 0), w1 = PACK4(p0, 8), w2 = PACK4(p1, 0), w3 = PACK4(p1, 8);
    asm volatile("s_waitcnt vmcnt(0)" ::: "memory");
    pv(o, vb, __builtin_bit_cast(bf16x8, w0), __builtin_bit_cast(bf16x8, w1), __builtin_bit_cast(bf16x8, w2), __builtin_bit_cast(bf16x8, w3));
}
struct WaveCtx { int lane, r32, hi, wid; LAS unsigned char* vslot; LAS float* wsf; int vb; };
__device__ __forceinline__ WaveCtx make_ctx(LAS unsigned char* lds, int slot_stride, int wave_id) {
    int lane_o = (int)__builtin_amdgcn_mbcnt_hi(~0u, __builtin_amdgcn_mbcnt_lo(~0u, 0u)); asm volatile("" : "+v"(lane_o));
    WaveCtx c; c.lane = lane_o; c.r32 = c.lane & 31; c.hi = c.lane >> 5; c.wid = wave_id;
    c.vslot = lds + c.wid * slot_stride; c.wsf = (LAS float*)(lds + EXTRA_OFF + 2048 + c.wid * 256);
    c.vb = (int)(unsigned)(uintptr_t)c.vslot + ((c.lane >> 4) & 1) * 32 + (c.lane & 3) * 8 + (4 * c.hi + ((c.lane & 15) >> 2)) * 64;
    return c;
}
__device__ __forceinline__ void store_o(const f32x16 (&o)[2], const WaveCtx& c, bf16* obuf, size_t row0, int col0, bool use_scale) {
#pragma unroll
    for (int r = 0; r < 16; ++r) { const int q = crow(r, c.hi); const float f = use_scale ? c.wsf[q] : 1.0f;
        bf16* op = obuf + (row0 + q) * DM + col0 + c.r32;
        op[0] = (bf16)(pk2(o[0][r] * f, 0.f) & 0xffffu); op[32] = (bf16)(pk2(o[1][r] * f, 0.f) & 0xffffu); }
}

__device__ __forceinline__ void load_k_t(bf16x8 (&kf)[8], const unsigned char* g0, const unsigned char* g1) {
#pragma unroll
    for (int d0 = 0; d0 < 4; ++d0) { kf[2 * d0] = *(const GAS bf16x8*)(g0 + d0 * 1024); kf[2 * d0 + 1] = *(const GAS bf16x8*)(g1 + d0 * 1024); }
}
__device__ __forceinline__ void stage_v_t(const unsigned char* v0, const unsigned char* v1, const unsigned char* v2, const unsigned char* v3, LAS unsigned char* slot) {
    const unsigned char* vg[4] = {v0, v1, v2, v3};
#pragma unroll
    for (int dh = 0; dh < 2; ++dh)
#pragma unroll
        for (int kg = 0; kg < 4; ++kg)
            __builtin_amdgcn_global_load_lds((const unsigned*)(vg[kg] + dh * 1024), (LAS unsigned*)(slot + (dh * 4 + kg) * 1024), 16, 0, 0);
}
constexpr size_t HB = pg8::EpiProj::HB;

__device__ __forceinline__ void attA_unit_s(int b, int h, int qb, const bf16* qbuf, const unsigned char* kv, const unsigned long long* maskw, bf16* obuf, LAS unsigned char* lds, float slope2, int wave_id) {
    const WaveCtx c = make_ctx(lds, 16384, wave_id);
    const int tq0 = 256 * qb + 32 * c.wid, t = tq0 + c.r32;
    const size_t rowbase = (size_t)b * SEQ;
    bf16x8 qr[4];
    { const bf16* Qp = qbuf + (rowbase + t) * QPITCH + QC_A + h * 64 + c.hi * 8;
#pragma unroll
      for (int d0 = 0; d0 < 4; ++d0) qr[d0] = *(const GAS bf16x8*)(Qp + 16 * d0); }
    const unsigned char* Ksrc = kv + pg8::EpiProj::KT_A + (size_t)(b * 4 + h) * HB + (size_t)(c.lane >> 5) * 4096 + c.wid * 512 + (c.lane & 31) * 16;
    const unsigned char* Vsrc = kv + pg8::EpiProj::VT_A + (size_t)(b * 4 + h) * HB + (size_t)(c.wid & 3) * 2048 + (c.wid >> 2) * 1024 + c.lane * 16;
    const unsigned long long* mwp = maskw + (size_t)b * 64 * SEQ + t;
    const int njw = (tq0 + 31) / 64 + 1, njb = 4 * qb + 4;
    LAS unsigned char* ring = lds;
    const int kfo = c.hi * 1024 + c.r32 * 16, vbo = ((c.lane >> 4) & 1) * 32 + (c.lane & 3) * 8 + (4 * c.hi + ((c.lane & 15) >> 2)) * 64;
#define ATA_DMA(J) do { LAS unsigned char* sl_ = ring + ((J) & 3) * 16384; \
        __builtin_amdgcn_global_load_lds((const unsigned*)(Ksrc + (size_t)(J) * 8192), (LAS unsigned*)(sl_ + c.wid * 1024), 16, 0, 0); \
        __builtin_amdgcn_global_load_lds((const unsigned*)(Vsrc + (size_t)(J) * 8192), (LAS unsigned*)(sl_ + 8192 + c.wid * 1024), 16, 0, 0); } while (0)
    float m = -1e30f, lsum = 0.f; f32x16 o[2]; o[0] = (f32x16){}; o[1] = (f32x16){};
    f32x16 bq0, bq1;
#pragma unroll
    for (int r = 0; r < 16; ++r) { const int cr = (r & 3) + 8 * (r >> 2); bq0[r] = slope2 * (float)(cr + 4 * c.hi - t); bq1[r] = slope2 * (float)(cr + 32 + 4 * c.hi - t); }
    const float fshift = 64.0f * slope2;
#define ATA_QK(J, P0, P1) do { const LAS unsigned char* ks_ = ring + ((J) & 3) * 16384 + kfo; bf16x8 kf_[8]; \
        _Pragma("unroll") for (int d0 = 0; d0 < 4; ++d0) { kf_[2 * d0] = *(const LAS bf16x8*)(ks_ + d0 * 2048); kf_[2 * d0 + 1] = *(const LAS bf16x8*)(ks_ + d0 * 2048 + 512); } \
        P0 = bq0; P1 = bq1; \
        _Pragma("unroll") for (int d0 = 0; d0 < 4; ++d0) { P0 = __builtin_amdgcn_mfma_f32_32x32x16_bf16(kf_[2 * d0], qr[d0], P0, 0, 0, 0); P1 = __builtin_amdgcn_mfma_f32_32x32x16_bf16(kf_[2 * d0 + 1], qr[d0], P1, 0, 0, 0); } } while (0)
    asm volatile("s_waitcnt lgkmcnt(0)\n\ts_barrier" ::: "memory");
    unsigned long long mw = mwp[0], mwn = 0ull;
    __builtin_amdgcn_sched_barrier(0);
    ATA_DMA(0); ATA_DMA(1); ATA_DMA(2);
    asm volatile("s_waitcnt vmcnt(4)\n\ts_barrier" ::: "memory");
    f32x16 p0, p1;
    ATA_QK(0, p0, p1);
#define ATA_ITER(DO_QK, DO_SM) do { \
        if (j + 1 < njb) {                                                              \
              \
              \
            if (j + 2 >= njb) asm volatile("s_waitcnt vmcnt(0)\n\ts_barrier" ::: "memory"); \
            else if (j == 0 || !((DO_QK) || (DO_SM))) asm volatile("s_waitcnt vmcnt(2)\n\ts_barrier" ::: "memory"); \
            else if (j == 1) asm volatile("s_waitcnt vmcnt(3)\n\ts_barrier" ::: "memory"); \
            else asm volatile("s_waitcnt vmcnt(4)\n\ts_barrier" ::: "memory"); } \
        if (j + 3 < njb) ATA_DMA(j + 3);                                                \
        if (DO_QK) { __builtin_amdgcn_sched_barrier(0); mwn = mwp[(size_t)(j + 1) * SEQ]; __builtin_amdgcn_sched_barrier(0); }        \
        f32x16 n0, n1; \
        if (DO_QK) ATA_QK(j + 1, n0, n1); \
        if (DO_SM) { \
            m -= fshift;                                                                \
            unsigned wv = c.hi ? (unsigned)(mw >> 32) : (unsigned)mw;                   \
            _Pragma("unroll") for (int r = 0; r < 16; ++r) { unsigned nw; const bool cy = __builtin_uadd_overflow(wv, wv, &nw); wv = nw; p0[r] = cy ? p0[r] : -INFINITY; } \
            _Pragma("unroll") for (int r = 0; r < 16; ++r) { unsigned nw; const bool cy = __builtin_uadd_overflow(wv, wv, &nw); wv = nw; p1[r] = cy ? p1[r] : -INFINITY; } \
            softmax_step(p0, p1, m, lsum, o, c.wsf, c.r32, c.hi); \
            const v4u w0 = PACK4(p0, 0), w1 = PACK4(p0, 8), w2 = PACK4(p1, 0), w3 = PACK4(p1, 8); \
            pv(o, (int)(unsigned)(uintptr_t)(ring + (j & 3) * 16384 + 8192) + vbo, __builtin_bit_cast(bf16x8, w0), __builtin_bit_cast(bf16x8, w1), __builtin_bit_cast(bf16x8, w2), __builtin_bit_cast(bf16x8, w3)); } \
        if (DO_QK) { p0 = n0; p1 = n1; } \
        mw = mwn; } while (0)
    int j = 0;
#pragma unroll 1
    for (; j + 1 < njw; ++j) ATA_ITER(true, true);
    ATA_ITER(false, true); ++j;
#pragma unroll 1
    for (; j < njb; ++j) ATA_ITER(false, false);
#undef ATA_ITER
#undef ATA_QK
#undef ATA_DMA
    const float l = swap_sum(lsum);
    if (c.hi == 0) c.wsf[c.r32] = 1.0f / l;
    store_o(o, c, obuf, rowbase + tq0, h * 64, true);
}

__device__ __forceinline__ void attB_unit(int b, int h, int qb, const bf16* qbuf, const unsigned char* kv, bf16* obuf, LAS unsigned char* lds, int wave_id) {
    const WaveCtx c = make_ctx(lds, 16384, wave_id);
    const int tq0 = 256 * qb + 32 * c.wid, t = tq0 + c.r32;
    const size_t rowbase = (size_t)b * SEQ;
    bf16x8 qr[4];
    { const bf16* Qp = qbuf + (rowbase + t) * QPITCH + QC_B + h * 64 + c.hi * 8;
#pragma unroll
      for (int d0 = 0; d0 < 4; ++d0) qr[d0] = *(const GAS bf16x8*)(Qp + 16 * d0); }
    const unsigned char* Kl = kv + pg8::EpiProj::KT_B + (size_t)(b * 4 + h) * HB + c.hi * 512 + c.r32 * 16;
    const unsigned char* Vl = kv + pg8::EpiProj::VT_B + (size_t)(b * 4 + h) * HB + c.lane * 16;
    const int jd = tq0 >> 6;
    float R = 0.f; f32x16 o[2]; o[0] = (f32x16){}; o[1] = (f32x16){};
    bf16x8 kf[8], kn[8];
    { const unsigned char* kt = Kl + (size_t)jd * 8192; load_k_t(kf, kt, kt + 4096);
      const unsigned char* vt = Vl + (size_t)jd * 8192; stage_v_t(vt, vt + 2048, vt + 4096, vt + 6144, c.vslot + (jd & 1) * 8192); }
    for (int j = jd; j >= 0; --j) {
        const bool more = (j > 0);
        if (more) { const unsigned char* kt = Kl + (size_t)(j - 1) * 8192; load_k_t(kn, kt, kt + 4096);
            const unsigned char* vt = Vl + (size_t)(j - 1) * 8192; stage_v_t(vt, vt + 2048, vt + 4096, vt + 6144, c.vslot + ((j - 1) & 1) * 8192); }
        f32x16 z0, z1; qkt(z0, z1, kf, qr);
        f32x16 L0, L1;
#pragma unroll
        for (int r = 0; r < 16; ++r) {
            L0[r] = -(fmaxf(z0[r], 0.f) + __builtin_amdgcn_logf(1.0f + __builtin_amdgcn_exp2f(-fabsf(z0[r]))));
            L1[r] = -(fmaxf(z1[r], 0.f) + __builtin_amdgcn_logf(1.0f + __builtin_amdgcn_exp2f(-fabsf(z1[r])))); }
        const bool diag = (j == jd);
        if (diag) {
#pragma unroll
            for (int r = 0; r < 16; ++r) { const int s = 64 * j + crow(r, c.hi); if (!(s < t)) L0[r] = 0.f; if (!(s + 32 < t)) L1[r] = 0.f; }
        }
        float gs[8], T[8], pr[8];
#pragma unroll
        for (int k = 0; k < 4; ++k) { gs[k] = (L0[4 * k] + L0[4 * k + 1]) + (L0[4 * k + 2] + L0[4 * k + 3]); gs[k + 4] = (L1[4 * k] + L1[4 * k + 1]) + (L1[4 * k + 2] + L1[4 * k + 3]); }
#pragma unroll
        for (int k = 0; k < 8; ++k) { auto rr = __builtin_amdgcn_permlane32_swap(__float_as_uint(gs[k]), __float_as_uint(gs[k]), false, false);
            const float lo = __uint_as_float(rr[0]), hv = __uint_as_float(rr[1]); T[k] = lo + hv; pr[k] = c.hi ? lo : hv; }
        float ST = 0.f;
#pragma unroll
        for (int k = 7; k >= 0; --k) {
            const float E = R + ST + (c.hi == 0 ? pr[k] : 0.f);
            if (k >= 4) { const int b4 = 4 * (k - 4);
                const float c3 = E, c2 = c3 + L1[b4 + 3], c1 = c2 + L1[b4 + 2], c0 = c1 + L1[b4 + 1];
                z1[b4 + 3] = __builtin_amdgcn_exp2f(z1[b4 + 3] + L1[b4 + 3] + c3); z1[b4 + 2] = __builtin_amdgcn_exp2f(z1[b4 + 2] + L1[b4 + 2] + c2);
                z1[b4 + 1] = __builtin_amdgcn_exp2f(z1[b4 + 1] + L1[b4 + 1] + c1); z1[b4] = __builtin_amdgcn_exp2f(z1[b4] + L1[b4] + c0);
            } else { const int b4 = 4 * k;
                const float c3 = E, c2 = c3 + L0[b4 + 3], c1 = c2 + L0[b4 + 2], c0 = c1 + L0[b4 + 1];
                z0[b4 + 3] = __builtin_amdgcn_exp2f(z0[b4 + 3] + L0[b4 + 3] + c3); z0[b4 + 2] = __builtin_amdgcn_exp2f(z0[b4 + 2] + L0[b4 + 2] + c2);
                z0[b4 + 1] = __builtin_amdgcn_exp2f(z0[b4 + 1] + L0[b4 + 1] + c1); z0[b4] = __builtin_amdgcn_exp2f(z0[b4] + L0[b4] + c0);
            }
            ST += T[k];
        }
        R += ST;
        if (diag) {
#pragma unroll
            for (int r = 0; r < 16; ++r) { const int s = 64 * j + crow(r, c.hi); if (!(s < t)) z0[r] = 0.f; if (!(s + 32 < t)) z1[r] = 0.f; }
        }
        pv_tile(o, z0, z1, c.vb + (j & 1) * 8192);
        if (__all(R < -150.0f)) break;
        if (more) {
#pragma unroll
            for (int i = 0; i < 8; ++i) kf[i] = kn[i]; }
    }
    asm volatile("s_waitcnt vmcnt(0)" ::: "memory");
    store_o(o, c, obuf, rowbase + tq0, 256 + h * 64, false);
}

__device__ __forceinline__ void attC_unit(int b, int h, int blk, const bf16* qbuf, const unsigned char* kv, bf16* obuf, LAS unsigned char* lds, float slope2, int wave_id) {
    const WaveCtx c = make_ctx(lds, 8192, wave_id);
    LAS bf16* oacc = (LAS bf16*)(lds + 65536); LAS float* lse = (LAS float*)(lds + EXTRA_OFF);
    const int T0 = 512 * blk; const size_t rowbase = (size_t)b * SEQ;
    unsigned wm0 = 0u, wm2 = 0u;
#pragma unroll
    for (int r = 0; r < 16; ++r) { wm0 |= (crow(r, c.hi) >= c.r32 ? 1u : 0u) << (31 - r); wm2 |= (crow(r, c.hi) <= c.r32 ? 1u : 0u) << (31 - r); }
#pragma unroll 1
    for (int br = 0; br < 3; ++br) {
        const int sh = 2 * br; const float sl2 = slope2 * (float)(1 << sh);
        f32x16 bq0; const float b32 = 32.0f * sl2;
#pragma unroll
        for (int r = 0; r < 16; ++r) bq0[r] = sl2 * (float)(crow(r, c.hi) - c.r32);
        const unsigned char* Kl = kv + pg8::EpiProj::KT_C + (size_t)br * pg8::EpiProj::DSTRIDE + (size_t)(b * 8 + h) * HB + c.hi * 512 + c.r32 * 16;
        const unsigned char* Vl = kv + pg8::EpiProj::VT_C + (size_t)(b * 8 + h) * HB + (c.lane & 3) * 16;
#pragma unroll 1
        for (int jj = 0; jj < 2; ++jj) {
            const int jt = c.wid + 8 * jj;
            int cc, u0;
            if (br == 0) { cc = 0; u0 = T0 + 32 * jt; } else if (br == 1) { cc = jt & 3; u0 = (T0 >> 2) + 32 * (jt >> 2); } else { cc = jt; u0 = T0 >> 4; }
            const int qu = u0 + c.r32, t = cc + (qu << sh);
            const int pc0 = cc << (12 - sh);
            bf16x8 qr[4];
            { const bf16* Qp = qbuf + (rowbase + t) * QPITCH + QC_C + h * 64 + c.hi * 8;
#pragma unroll
              for (int d0 = 0; d0 < 4; ++d0) qr[d0] = *(const GAS bf16x8*)(Qp + 16 * d0); }
            float m = -1e30f, lsum = 0.f; f32x16 o[2]; o[0] = (f32x16){}; o[1] = (f32x16){};
            const int g1 = (160 - u0) > 32 ? ((160 - u0) >> 5) : 1;
            bf16x8 kf[8];
            if (g1 == 1) {
                const int ku0 = u0 - 160;
                { const unsigned char* g1p = Kl + (size_t)((pc0 + ku0 + 32) >> 5) * 4096;
#pragma unroll
                  for (int d0 = 0; d0 < 4; ++d0) kf[2 * d0 + 1] = *(const GAS bf16x8*)(g1p + d0 * 1024); }
#pragma unroll
                for (int kg = 2; kg < 4; ++kg) { const int kvs = ku0 + 16 * kg + (c.lane >> 2), p = cc + (kvs << sh); const unsigned char* vg = Vl + (size_t)(p >> 4) * 2048 + (p & 15) * 64;
#pragma unroll
                    for (int dh = 0; dh < 2; ++dh) __builtin_amdgcn_global_load_lds((const unsigned*)(vg + dh * 1024), (LAS unsigned*)(c.vslot + (dh * 4 + kg) * 1024), 16, 0, 0); }
                f32x16 p1;
#pragma unroll
                for (int r = 0; r < 16; ++r) p1[r] = bq0[r] + b32;
#pragma unroll
                for (int d0 = 0; d0 < 4; ++d0) p1 = __builtin_amdgcn_mfma_f32_32x32x16_bf16(kf[2 * d0 + 1], qr[d0], p1, 0, 0, 0);
                __builtin_amdgcn_sched_barrier(0);
                load_k_t(kf, Kl + (size_t)((pc0 + ku0 + 64) >> 5) * 4096, Kl + (size_t)((pc0 + ku0 + 96) >> 5) * 4096);
                { unsigned wv = wm0;
#pragma unroll
                  for (int r = 0; r < 16; ++r) { unsigned nw; const bool cy = __builtin_uadd_overflow(wv, wv, &nw); wv = nw; p1[r] = cy ? p1[r] : -INFINITY; } }
                softmax_step1(p1, m, lsum, o, c.wsf, c.r32, c.hi);
                const v4u w2 = PACK4(p1, 0), w3 = PACK4(p1, 8);
                asm volatile("s_waitcnt vmcnt(8)" ::: "memory");
                pv_half(o, c.vb, __builtin_bit_cast(bf16x8, w2), __builtin_bit_cast(bf16x8, w3));
            } else {
                const int kts = g1 >> 1, ka = u0 - 160 + 64 * kts;
                load_k_t(kf, Kl + (size_t)((pc0 + (ka < 0 ? 0 : ka)) >> 5) * 4096, Kl + (size_t)((pc0 + ka + 32) >> 5) * 4096);
            }
#pragma unroll 1
            for (int kt = (g1 == 1 ? 1 : (g1 >> 1)); kt < 3; ++kt) {
                const int ku0 = u0 - 160 + 64 * kt;
                const bool p0dead = (g1 == 2 * kt + 1);
                m -= 64.0f * sl2;
                f32x16 p0 = bq0, p1;
#pragma unroll
                for (int r = 0; r < 16; ++r) p1[r] = bq0[r] + b32;
#pragma unroll
                for (int d0 = 0; d0 < 4; ++d0) { p0 = __builtin_amdgcn_mfma_f32_32x32x16_bf16(kf[2 * d0], qr[d0], p0, 0, 0, 0); p1 = __builtin_amdgcn_mfma_f32_32x32x16_bf16(kf[2 * d0 + 1], qr[d0], p1, 0, 0, 0); }
                { const unsigned char* vg[4];
#pragma unroll
                  for (int kg = 0; kg < 4; ++kg) { const int kvs = ku0 + 16 * kg + (c.lane >> 2), p = cc + ((kvs < 0 ? 0 : kvs) << sh);
                      vg[kg] = Vl + (size_t)(p >> 4) * 2048 + (p & 15) * 64; }
                  stage_v_t(vg[0], vg[1], vg[2], vg[3], c.vslot); }
                __builtin_amdgcn_sched_barrier(0);
                if (kt < 2) { const int ka = ku0 + 64; load_k_t(kf, Kl + (size_t)((pc0 + ka) >> 5) * 4096, Kl + (size_t)((pc0 + ka + 32) >> 5) * 4096); }
                if (p0dead) {
#pragma unroll
                    for (int r = 0; r < 16; ++r) p0[r] = -INFINITY; }
                if (kt == 2) { unsigned wv = wm2;
#pragma unroll
                    for (int r = 0; r < 16; ++r) { unsigned nw; const bool cy = __builtin_uadd_overflow(wv, wv, &nw); wv = nw; p1[r] = cy ? p1[r] : -INFINITY; } }
                softmax_step(p0, p1, m, lsum, o, c.wsf, c.r32, c.hi);
                const v4u w0 = PACK4(p0, 0), w1 = PACK4(p0, 8), w2 = PACK4(p1, 0), w3 = PACK4(p1, 8);
                if (kt < 2) asm volatile("s_waitcnt vmcnt(8)" ::: "memory"); else asm volatile("s_waitcnt vmcnt(0)" ::: "memory");
                pv(o, c.vb, __builtin_bit_cast(bf16x8, w0), __builtin_bit_cast(bf16x8, w1), __builtin_bit_cast(bf16x8, w2), __builtin_bit_cast(bf16x8, w3));
            }
            const float l = swap_sum(lsum), lb = m - 32.0f * sl2 + __builtin_amdgcn_logf(l);
            const int tl = t - T0;
            if (c.hi == 0) { c.wsf[c.r32] = 1.0f / l; c.wsf[32 + c.r32] = lb; }
            float lnew = lb;
            if (br > 0) { const float lo = lse[tl], mx = fmaxf(lo, lb); lnew = mx + __builtin_amdgcn_logf(__builtin_amdgcn_exp2f(lo - mx) + __builtin_amdgcn_exp2f(lb - mx)); }
#pragma unroll
            for (int r = 0; r < 16; ++r) { const int q = crow(r, c.hi); const int tlr = cc + ((u0 + q) << sh) - T0;
                const float inv = c.wsf[q]; float v0 = o[0][r] * inv, v1 = o[1][r] * inv;
                if (br > 0) { const float lbr = c.wsf[32 + q], lo = lse[tlr], mx = fmaxf(lo, lbr), eo = __builtin_amdgcn_exp2f(lo - mx), eb = __builtin_amdgcn_exp2f(lbr - mx), rd = 1.0f / (eo + eb);
                    const float wo = eo * rd, wb = eb * rd;
                    v0 = wo * bf2f(oacc[tlr * 64 + c.r32]) + wb * v0; v1 = wo * bf2f(oacc[tlr * 64 + 32 + c.r32]) + wb * v1; }
                if (br < 2) { oacc[tlr * 64 + c.r32] = (bf16)(pk2(v0, 0.f) & 0xffffu); oacc[tlr * 64 + 32 + c.r32] = (bf16)(pk2(v1, 0.f) & 0xffffu); }
                else { bf16* op = obuf + (rowbase + T0 + tlr) * DM + 512 + h * 64 + c.r32; op[0] = (bf16)(pk2(v0, 0.f) & 0xffffu); op[32] = (bf16)(pk2(v1, 0.f) & 0xffffu); }
            }
            LDS_WAIT();
            if (br < 2 && c.hi == 0) lse[tl] = lnew;
        }
        __syncthreads();
    }
}
#undef SBAR
}

__device__ __forceinline__ unsigned mask_e16(unsigned X) { return (X & 0xFu) | ((X >> 4) & 0xF0u) | ((X >> 8) & 0xF00u) | ((X >> 12) & 0xF000u); }
__device__ __forceinline__ unsigned long long mask_perm(unsigned lo, unsigned hi) {
    const unsigned w0 = __builtin_bitreverse32(mask_e16(lo) | (mask_e16(hi) << 16)), w1 = __builtin_bitreverse32(mask_e16(lo >> 4) | (mask_e16(hi >> 4) << 16));
    return ((unsigned long long)w1 << 32) | w0;
}
__device__ __forceinline__ int row_sum_dpp(int v) {
    v += __builtin_amdgcn_update_dpp(0, v, 0xB1, 0xF, 0xF, true); v += __builtin_amdgcn_update_dpp(0, v, 0x4E, 0xF, 0xF, true);
    v += __builtin_amdgcn_update_dpp(0, v, 0x141, 0xF, 0xF, true); v += __builtin_amdgcn_update_dpp(0, v, 0x140, 0xF, 0xF, true);
    return v;
}
constexpr int IDX_R = 3, IDX_STAGE = 16384;
#define IDX_NG 32
__device__ __forceinline__ void idx_phase(Frame& F, const bf16* qbuf, const unsigned char* kv, const float* wi32, unsigned long long* maskw, unsigned long long& pt_acc, unsigned long long& pt_t0) {
    typedef float f32x4_ __attribute__((ext_vector_type(4)));
    const int lane = F.lane, l15 = lane & 15, lg = lane >> 4, half = lane >> 5, l31 = lane & 31, wid = F.wave;
    LAS unsigned char* ring = F.lds;
    LAS unsigned* candl = (LAS unsigned*)(F.lds + EXTRA_OFF + 2048 + wid * 256);
    LAS unsigned long long* mstage = (LAS unsigned long long*)(F.lds + 65536);
    LAS unsigned char* qstage = F.lds + 73728 + wid * 3072;
    bool pref = false;
    float zA0 = 1.2f, zA1 = 1.2f;
    (void)pt_acc; (void)pt_t0;
#ifdef ITER_PROBE
    unsigned* itcnt = (unsigned*)maskw - 0; itcnt = (unsigned*)((unsigned char*)kv - (WS_KV - WS_CTL)) + 2048 + 16;
#endif
#pragma unroll 1
    for (int u = F.bid; u < NB * 256; u += F.G) {
        PT_START(6);
        const int b = u >> 8, rb = u & 255, qg = (b & 1) ? 255 - rb : rb, t0 = 16 * qg, upar = b & 1;
        const size_t rowbase = (size_t)b * SEQ;
        const int tq = t0 + 2 * wid + half;
        unsigned mAlo = 0u, mAhi = 0u, mBlo = 0u, mBhi = 0u;
        if (t0 + 15 < 256) {
#pragma unroll
            for (int j = 0; j < 4; ++j) { const unsigned long long ma = __ballot(64 * j + lane <= t0 + 2 * wid), mb = __ballot(64 * j + lane <= t0 + 2 * wid + 1);
                if (lane == j) { mAlo = (unsigned)ma; mAhi = (unsigned)(ma >> 32); mBlo = (unsigned)mb; mBhi = (unsigned)(mb >> 32); } }
        } else {
            const int nst = (t0 + 16 + 127) >> 7;
            bf16x8 qf[2]; f32x4_ wq;
            const unsigned char* ksrc = kv + pg8::EpiProj::KT_I + (size_t)b * pg8::EpiProj::HB + (size_t)(lane >> 5) * 4096 + l31 * 16;
#define IDX_DMAP(KS, S) do { _Pragma("unroll") for (int dd = 0; dd < 2; ++dd) { const int p_ = wid * 2 + dd, hf_ = p_ >> 3, c_ = p_ & 7; \
                __builtin_amdgcn_global_load_lds((const unsigned*)((KS) + (size_t)(S) * 16384 + hf_ * 8192 + c_ * 512), (LAS unsigned*)(ring + ((S) % IDX_R) * IDX_STAGE + hf_ * 8192 + c_ * 1024), 16, 0, 0); } } while (0)
#define IDX_DMA(S) IDX_DMAP(ksrc, S)
#define IDX_QDMA(RB, T0_) do { const bf16* qp_ = qbuf + ((RB) + (T0_) + 2 * wid + (l15 >> 3)) * QPITCH + QC_I + (l15 & 7) * 64 + 8 * lg; \
                __builtin_amdgcn_global_load_lds((const unsigned*)qp_, (LAS unsigned*)qstage, 16, 0, 0); __builtin_amdgcn_global_load_lds((const unsigned*)(qp_ + 32), (LAS unsigned*)(qstage + 1024), 16, 0, 0); \
                __builtin_amdgcn_global_load_lds((const unsigned*)(wi32 + ((RB) + (T0_) + 2 * wid + half) * 8 + 4 * (lg & 1)), (LAS unsigned*)(qstage + 2048), 16, 0, 0); } while (0)
            unsigned x[4 * IDX_NG]; float ssum = 0.f, ssq = 0.f;
#ifndef IDX2_REP_SCORE
#define IDX2_REP_SCORE 1
#endif
#ifndef IDX2_REP_SEL
#define IDX2_REP_SEL 1
#endif
            PT_STOP(6); PT_START(1);
            _Pragma("unroll 1") for (int reps_ = 0; reps_ < IDX2_REP_SCORE; ++reps_) {
            if (!pref) {
                asm volatile("s_waitcnt lgkmcnt(0)\n\ts_barrier" ::: "memory");
                IDX_QDMA(rowbase, t0); IDX_DMA(0); IDX_DMA(1); }
            asm volatile("s_waitcnt vmcnt(4)" ::: "memory");
            qf[0] = *(const LAS bf16x8*)(qstage + lane * 16); qf[1] = *(const LAS bf16x8*)(qstage + 1024 + lane * 16); wq = *(const LAS f32x4_*)(qstage + 2048 + lane * 16);
            LDS_WAIT();
#pragma unroll
            for (int s = 0; s < IDX_NG; ++s) {
                if (s < nst) {
                    if (s + 1 < nst) asm volatile("s_waitcnt vmcnt(2)\n\ts_barrier" ::: "memory"); else asm volatile("s_waitcnt vmcnt(0)\n\ts_barrier" ::: "memory");
                    const LAS unsigned char* slot = ring + (s % IDX_R) * IDX_STAGE + lg * 1024 + l15 * 16;
#define IDX_LDF(FR, J) do { _Pragma("unroll") for (int tt = 0; tt < 2; ++tt) { const int k64 = (32 * (J) + 16 * tt) & 63, hf = (32 * (J) + 16 * tt) >> 6; \
                        FR[2 * tt] = *(const LAS bf16x8*)(slot + hf * 8192 + k64 * 16); FR[2 * tt + 1] = *(const LAS bf16x8*)(slot + hf * 8192 + 4096 + k64 * 16); } } while (0)
                    bf16x8 fa[4], fb[4];
                    IDX_LDF(fa, 0);
#pragma unroll
                    for (int j = 0; j < 4; ++j) {
                        if (j + 1 < 4) { if (j & 1) IDX_LDF(fa, j + 1); else IDX_LDF(fb, j + 1); }
                        if ((j & 1) == 0) __builtin_amdgcn_sched_barrier(0);
                        float part[2];
#pragma unroll
                        for (int tt = 0; tt < 2; ++tt) {
                            const bf16x8 b0 = (j & 1) ? fb[2 * tt] : fa[2 * tt], b1 = (j & 1) ? fb[2 * tt + 1] : fa[2 * tt + 1];
                            f32x4_ acc = __builtin_amdgcn_mfma_f32_16x16x32_bf16(qf[0], b0, (f32x4_){0.f, 0.f, 0.f, 0.f}, 0, 0, 0);
                            acc = __builtin_amdgcn_mfma_f32_16x16x32_bf16(qf[1], b1, acc, 0, 0, 0);
                            const float r0_ = __int_as_float(max(__float_as_int(acc[0]), 0)), r1_ = __int_as_float(max(__float_as_int(acc[1]), 0)), r2_ = __int_as_float(max(__float_as_int(acc[2]), 0)), r3_ = __int_as_float(max(__float_as_int(acc[3]), 0));
                            part[tt] = fmaf(wq[3], r3_, fmaf(wq[2], r2_, fmaf(wq[1], r1_, wq[0] * r0_))); }
                        auto sw = __builtin_amdgcn_permlane16_swap(__float_as_uint(part[0]), __float_as_uint(part[1]), false, false);
                        const float v = (__uint_as_float(sw[0]) + __uint_as_float(sw[1])) + 0.0f;
                        unsigned uu = __float_as_uint(v); uu ^= ((unsigned)((int)uu >> 31) & 0x7FFFFFFFu);
                        const bool vld = (128 * (s + 1) <= t0 || 128 * s + 32 * j + l31 <= tq);
                        x[4 * s + j] = vld ? uu : 0x80000000u;
                        const float vz = vld ? v : 0.f; ssum += vz; ssq = fmaf(vz, vz, ssq);
                        if (j == 1 && s + 2 < nst) IDX_DMA(s + 2);
                    }
#undef IDX_LDF
                } else {
#pragma unroll
                    for (int j = 0; j < 4; ++j) x[4 * s + j] = 0x80000000u;
                }
            }
            }
            pref = false;
            { const int un = u + F.G;
              if (un < NB * 256) { const int bn = un >> 8, rbn = un & 255, qgn = (bn & 1) ? 255 - rbn : rbn, t0n = 16 * qgn;
                  if (t0n + 15 >= 256) {
                      asm volatile("s_waitcnt lgkmcnt(0)\n\ts_barrier" ::: "memory");
                      const unsigned char* ksn = kv + pg8::EpiProj::KT_I + (size_t)bn * pg8::EpiProj::HB + (size_t)(lane >> 5) * 4096 + l31 * 16;
                      IDX_QDMA((size_t)bn * SEQ, t0n); IDX_DMAP(ksn, 0); IDX_DMAP(ksn, 1); pref = true; } } }
            PT_STOP(1);
#undef IDX_DMA
#undef IDX_DMAP
#undef IDX_QDMA
            const int nb32 = (nst + 7) >> 3;
#define IDX_COUNT_LT(GV, CA, CB) do { unsigned cl_ = 0u; \
                _Pragma("unroll") for (int bq = 0; bq < 4; ++bq) if (bq < nb32) { unsigned a0_ = 0u, a1_ = 0u, a2_ = 0u, a3_ = 0u; \
                    _Pragma("unroll") for (int jq = 0; jq < 32; jq += 4) { \
                        a0_ = __builtin_amdgcn_alignbit(a0_, (unsigned)__builtin_elementwise_sub_sat((int)x[32 * bq + jq], (GV)), 31); a1_ = __builtin_amdgcn_alignbit(a1_, (unsigned)__builtin_elementwise_sub_sat((int)x[32 * bq + jq + 1], (GV)), 31); \
                        a2_ = __builtin_amdgcn_alignbit(a2_, (unsigned)__builtin_elementwise_sub_sat((int)x[32 * bq + jq + 2], (GV)), 31); a3_ = __builtin_amdgcn_alignbit(a3_, (unsigned)__builtin_elementwise_sub_sat((int)x[32 * bq + jq + 3], (GV)), 31); } \
                    cl_ += __builtin_popcount(a0_) + __builtin_popcount(a1_) + __builtin_popcount(a2_) + __builtin_popcount(a3_); } \
                const int rs_ = row_sum_dpp((int)cl_); \
                CA = __builtin_amdgcn_readlane(rs_, 0) + __builtin_amdgcn_readlane(rs_, 16); CB = __builtin_amdgcn_readlane(rs_, 32) + __builtin_amdgcn_readlane(rs_, 48); } while (0)
            PT_START(2);
            const int nel = 1024 * nb32;
            float mu[2], sg[2];
            { float s1 = ssum, s2 = ssq;
              s1 = PG8_DPP_ADD(s1, 0xB1); s1 = PG8_DPP_ADD(s1, 0x4E); s1 = PG8_DPP_ADD(s1, 0x141); s1 = PG8_DPP_ADD(s1, 0x140);
              s2 = PG8_DPP_ADD(s2, 0xB1); s2 = PG8_DPP_ADD(s2, 0x4E); s2 = PG8_DPP_ADD(s2, 0x141); s2 = PG8_DPP_ADD(s2, 0x140);
#pragma unroll
              for (int q = 0; q < 2; ++q) { const float nq = (float)(t0 + 2 * wid + 1 + q);
                  const float a1 = __builtin_bit_cast(float, __builtin_amdgcn_readlane(__builtin_bit_cast(int, s1), 32 * q)) + __builtin_bit_cast(float, __builtin_amdgcn_readlane(__builtin_bit_cast(int, s1), 32 * q + 16));
                  const float a2 = __builtin_bit_cast(float, __builtin_amdgcn_readlane(__builtin_bit_cast(int, s2), 32 * q)) + __builtin_bit_cast(float, __builtin_amdgcn_readlane(__builtin_bit_cast(int, s2), 32 * q + 16));
                  mu[q] = a1 / nq; sg[q] = sqrtf(fmaxf(a2 / nq - mu[q] * mu[q], 1e-12f)); } }
            const float zprev = upar ? zA1 : zA0;
            int lo[2] = {(int)0x80000001, (int)0x80000001}, hi_k[2] = {0x7FFFFFFF, 0x7FFFFFFF}, probe[2]; unsigned step[2];
#pragma unroll
            for (int q = 0; q < 2; ++q) { const float pv_ = mu[q] + zprev * sg[q], pw_ = pv_ + 0.04f * sg[q];
                int k0 = __float_as_int(pv_ + 0.f), k1 = __float_as_int(pw_ + 0.f); k0 ^= (k0 >> 31) & 0x7FFFFFFF; k1 ^= (k1 >> 31) & 0x7FFFFFFF;
                probe[q] = k0; const unsigned st_ = (unsigned)(k1 - k0); step[q] = st_ < 256u ? 256u : (st_ > (1u << 24) ? (1u << 24) : st_); }
            int clo[2] = {t0 + 2 * wid + 1, t0 + 2 * wid + 2}, chi[2] = {0, 0}; bool hl[2] = {false, false}, hh[2] = {false, false}, dn[2] = {false, false};
#pragma unroll 1
            for (int it = 0; it < 96; ++it) {
                int gg[2];
#pragma unroll
                for (int q = 0; q < 2; ++q) { const unsigned wdt = (unsigned)hi_k[q] - (unsigned)lo[q];
                    dn[q] = dn[q] || (clo[q] - chi[q] <= 32) || (wdt <= 1u);
                    int g_ = (hl[q] && hh[q]) ? (int)((unsigned)lo[q] + (wdt >> 1)) : probe[q];
                    if (g_ <= lo[q] || g_ >= hi_k[q]) g_ = (int)((unsigned)lo[q] + (wdt >> 1));
                    gg[q] = dn[q] ? lo[q] : g_; }
                if (dn[0] && dn[1]) break;
#ifdef ITER_PROBE
                if (lane == 0) atomicAdd(itcnt, 1u);
#endif
                const int gv = half ? gg[1] : gg[0];
                int cl2[2]; IDX_COUNT_LT(gv, cl2[0], cl2[1]);
#pragma unroll
                for (int q = 0; q < 2; ++q) if (!dn[q]) { const int cn = nel - cl2[q];
                    if (cn >= 256) { lo[q] = gg[q]; clo[q] = cn; hl[q] = true; const long long p_ = (long long)gg[q] + (long long)step[q]; probe[q] = p_ > 0x7FFFFFFELL ? 0x7FFFFFFE : (int)p_; }
                    else { hi_k[q] = gg[q]; chi[q] = cn; hh[q] = true; const long long p_ = (long long)gg[q] - (long long)step[q]; probe[q] = p_ < -0x7FFFFFFELL ? -0x7FFFFFFE : (int)p_; }
                    step[q] <<= 1; if (step[q] == 0u) step[q] = 1u << 31;
                    if (it == 0) {
                        const float zz = fmaxf(zprev, 0.5f), dv0 = sg[q] * __logf(fmaxf((float)cn, 0.5f) * (1.0f / 256.0f)) / (zz + 1.0f / zz) * 1.25f;
                        const float dv = (cn >= 256) ? fmaxf(dv0, 0.01f * sg[q]) : fminf(dv0, -0.01f * sg[q]);
                        int k2 = __float_as_int((mu[q] + zprev * sg[q]) + dv + 0.f); k2 ^= (k2 >> 31) & 0x7FFFFFFF; probe[q] = k2;
                        const unsigned d_ = (unsigned)(k2 > gg[q] ? k2 - gg[q] : gg[q] - k2); step[q] = d_ < 256u ? 256u : d_; } }
            }
            PT_STOP(2); PT_START(3);
            const int lov = half ? lo[1] : lo[0], hiv = half ? hi_k[1] : hi_k[0];
            const bool tieA = ((unsigned)hi_k[0] - (unsigned)lo[0] <= 1u), tieB = ((unsigned)hi_k[1] - (unsigned)lo[1] <= 1u);
            int baseA = 0, baseB = 0;
#pragma unroll
            for (int bq = 0; bq < 4; ++bq) if (bq < nb32) {
#pragma unroll
                for (int jq = 0; jq < 32; jq += 4) {
                    bool mt[4]; bool any4 = false;
#pragma unroll
                    for (int k = 0; k < 4; ++k) { const int xv = (int)x[32 * bq + jq + k]; mt[k] = (xv >= lov) && (xv < hiv); any4 = any4 || mt[k]; }
                    if (__ballot(any4)) {
#pragma unroll
                        for (int k = 0; k < 4; ++k) { const unsigned long long bm = __ballot(mt[k]); const unsigned bl = (unsigned)bm, bh = (unsigned)(bm >> 32);
                            const int pos = half ? baseB + (int)__builtin_amdgcn_mbcnt_hi(bh, 0u) : baseA + (int)__builtin_amdgcn_mbcnt_lo(bl, 0u);
                            if (mt[k] && pos < 32) candl[half * 32 + pos] = x[32 * bq + jq + k];
                            baseA += __builtin_popcount(bl); baseB += __builtin_popcount(bh); } }
                    asm volatile("" : "+s"(baseA), "+s"(baseB) :: "memory"); }
            }
            const int mcA = tieA ? 0 : clo[0] - chi[0], mcB = tieB ? 0 : clo[1] - chi[1], mcv = half ? mcB : mcA, mcmax = mcA > mcB ? mcA : mcB;
            const int needv = 256 - (half ? chi[1] : chi[0]);
            const int my = (l31 < mcv) ? (int)candl[half * 32 + l31] : (int)0x80000000;
            int cge = 0;
            LDS_WAIT();
#pragma unroll 4
            for (int j = 0; j < mcmax; ++j) { const int cj = (j < mcv) ? (int)candl[half * 32 + j] : (int)0x80000000; cge += (cj >= my) ? 1 : 0; }
            const bool okc = (l31 < mcv) && (cge >= needv);
            int vsel[2], cgt[2], neqA, neqB;
            { int vm = okc ? my : (int)0x80000000;
              vm = max(vm, __builtin_amdgcn_update_dpp((int)0x80000000, vm, 0xB1, 0xF, 0xF, false)); vm = max(vm, __builtin_amdgcn_update_dpp((int)0x80000000, vm, 0x4E, 0xF, 0xF, false));
              vm = max(vm, __builtin_amdgcn_update_dpp((int)0x80000000, vm, 0x141, 0xF, 0xF, false)); vm = max(vm, __builtin_amdgcn_update_dpp((int)0x80000000, vm, 0x140, 0xF, 0xF, false));
              { auto t_ = __builtin_amdgcn_permlane16_swap((unsigned)vm, (unsigned)vm, false, false); vm = max((int)t_[0], (int)t_[1]); }
              const int bA = __builtin_amdgcn_readlane(vm, 0), bB = __builtin_amdgcn_readlane(vm, 32);
              vsel[0] = tieA ? lo[0] : bA; vsel[1] = tieB ? lo[1] : bB;
              const int vv_ = half ? vsel[1] : vsel[0];
              const unsigned long long gtm = __ballot((l31 < mcv) && (my > vv_)), eqm = __ballot((l31 < mcv) && (my == vv_));
              cgt[0] = chi[0] + (tieA ? 0 : __builtin_popcount((unsigned)gtm)); cgt[1] = chi[1] + (tieB ? 0 : __builtin_popcount((unsigned)(gtm >> 32)));
              neqA = tieA ? clo[0] - chi[0] : __builtin_popcount((unsigned)eqm); neqB = tieB ? clo[1] - chi[1] : __builtin_popcount((unsigned)(eqm >> 32)); }
            PT_STOP(3); PT_START(4);
            { int kb_ = vsel[0]; kb_ ^= (kb_ >> 31) & 0x7FFFFFFF; const float tv_ = __int_as_float(kb_), zn_ = (tv_ - mu[0]) / sg[0]; if (upar) zA1 = zn_; else zA0 = zn_; }
            const int vv = half ? vsel[1] : vsel[0];
            const int ntkA = 256 - cgt[0], ntkB = 256 - cgt[1];
#define IDX_PUT(MM, R) do { const unsigned ml_ = (unsigned)(MM), mh_ = (unsigned)((MM) >> 32); \
                if (((R) & 1) == 0) asm volatile("s_nop 1\n\tv_writelane_b32 %0, %2, %4\n\tv_writelane_b32 %1, %3, %4" : "+v"(mAlo), "+v"(mBlo) : "s"(ml_), "s"(mh_), "i"((R) >> 1)); \
                else                asm volatile("s_nop 1\n\tv_writelane_b32 %0, %2, %4\n\tv_writelane_b32 %1, %3, %4" : "+v"(mAhi), "+v"(mBhi) : "s"(ml_), "s"(mh_), "i"((R) >> 1)); } while (0)
            if (neqA == ntkA && neqB == ntkB) {
#pragma unroll
                for (int bq = 0; bq < 4; ++bq) if (bq < nb32) {
#pragma unroll
                    for (int jq = 0; jq < 32; ++jq) { const unsigned long long mm = __ballot((int)x[32 * bq + jq] >= vv); IDX_PUT(mm, 32 * bq + jq); }
                }
            } else {
                int takenA = 0, takenB = 0; const int ntkv = half ? ntkB : ntkA;
#pragma unroll
                for (int bq = 0; bq < 4; ++bq) if (bq < nb32) {
#pragma unroll
                    for (int jq = 0; jq < 32; ++jq) { const int r = 32 * bq + jq; const bool eq = ((int)x[r] == vv), gt = ((int)x[r] > vv);
                        const unsigned long long eqm = __ballot(eq); const unsigned el = (unsigned)eqm, eh = (unsigned)(eqm >> 32);
                        const int rank = half ? takenB + (int)__builtin_amdgcn_mbcnt_hi(eh, 0u) : takenA + (int)__builtin_amdgcn_mbcnt_lo(el, 0u);
                        const unsigned long long mm = __ballot(gt || (eq && rank < ntkv)); IDX_PUT(mm, r);
                        takenA += __builtin_popcount(el); takenB += __builtin_popcount(eh);
                        asm volatile("" : "+s"(takenA), "+s"(takenB)); }
                }
            }
            PT_STOP(4);
#undef IDX_PUT
#undef IDX_COUNT_LT
        }
        PT_START(5);
#ifdef ICACHE_PROBE
        { unsigned dd_ = mAlo; asm volatile(".rept 8000\n\tv_add_u32 %0, 1, %0\n\t.endr" : "+v"(dd_)); if (dd_ == 0x12345u) mAlo ^= 1u; }
#endif
        mstage[lane * 16 + 2 * wid] = mask_perm(mAlo, mAhi); mstage[lane * 16 + 2 * wid + 1] = mask_perm(mBlo, mBhi);
        __syncthreads();
#pragma unroll
        for (int k = 0; k < 2; ++k) { const int e = F.tid + 512 * k; maskw[((size_t)b * 64 + (e >> 4)) * SEQ + t0 + (e & 15)] = mstage[e]; }
        __syncthreads();
        PT_STOP(5);
    }
}

#ifdef ITER_PROBE
#define ITERP 1
#else
#define ITERP 0
#endif
#ifdef REPBAR
#define BAR2X(B) xcd_barrier(B);
#else
#define BAR2X(B)
#endif
#ifndef MK_SPLIT
#define MK_SPLIT 0
#endif
constexpr int N_PHASES = 25;

__global__ void __launch_bounds__(NWAVES * 64, 2) fwd_kernel(Ptrs Pin) {
    typedef const __attribute__((address_space(4))) Ptrs* KargPtr;
    extern __shared__ __attribute__((aligned(16))) unsigned char lds_raw[];
    Frame F;
    F.lds = (LAS unsigned char*)lds_raw;
    volatile LAS unsigned* MISC = (volatile LAS unsigned*)(F.lds + MISC_OFF);
    F.tid = threadIdx.x; F.lane = F.tid & 63; F.wave = __builtin_amdgcn_readfirstlane(F.tid >> 6);
    F.bid = blockIdx.x; F.G = gridDim.x; { const int bx = blockIdx.x; F.vcu = (F.G % 8 == 0) ? (bx % 8) * (F.G / 8) + bx / 8 : bx; }
    for (int u = F.tid; u < (LDS_BYTES - LDSCTL_OFF) / 4; u += NWAVES * 64) ((LAS unsigned*)(F.lds + LDSCTL_OFF))[u] = 0u;
    __syncthreads();
    unsigned* ctl = (unsigned*)(Pin.ws + WS_CTL);
    if (!MK_SPLIT) (void)xcd_barrier_post(ctl + CW_BAR, MISC + 8);
    const int lo = Pin.ph_lo, hi = Pin.ph_hi; (void)lo; (void)hi;
    int ph = 0;
    unsigned long long pt_acc = 0ull, pt_t0 = 0ull; (void)pt_acc; (void)pt_t0;
#if MK_SPLIT
#define PH_COND (lo <= ph && ph < hi)
#else
#define PH_COND true
#endif
#define PH_BEGIN if (PH_COND) { asm volatile("" : "+s"(F.wave), "+s"(F.vcu), "+s"(F.G), "+s"(F.bid)); F.lane = (int)__builtin_amdgcn_mbcnt_hi(~0u, __builtin_amdgcn_mbcnt_lo(~0u, 0u)); asm volatile("" : "+v"(F.lane)); F.tid = F.wave * 64 + F.lane; KargPtr pk_ = (KargPtr)__builtin_amdgcn_kernarg_segment_ptr(); asm volatile("" : "+s"(pk_)); PT_START(100 + ph); PT_START(200 + ph);
#define PH_END   PT_STOP(200 + ph); if (!MK_SPLIT && (ph + 1 < N_PHASES || PROBE_T || ITERP)) { unsigned char* wsx_ = P.ws; XcdBarrier b2_; b2_.bar = (unsigned*)(wsx_ + WS_CTL) + CW_BAR; b2_.x = xb_xcc_id(); b2_.st = MISC + 8; b2_.t0 = (F.tid == 0); xcd_barrier(b2_); BAR2X(b2_) } PT_STOP(100 + ph); } ++ph;

#define P (*pk_)
#define H ((bf16*)(P.ws + WS_H))
#define QBUF ((bf16*)(P.ws + WS_Q))
#define KVB ((unsigned char*)(P.ws + WS_KV))
#define WI32 ((float*)(P.ws + WS_WI))
#define ACT ((bf16*)(P.ws + WS_KV))
#define OB ((bf16*)(P.ws + WS_H))
#define MASKW ((unsigned long long*)(P.ws + WS_MASK))
#define wl (P.ws + WS_W + (size_t)l * LAYER_W_BYTES)
#define modl ((const float*)(P.ws + WS_MOD) + (size_t)l * NB * NMODC)
#define XB ((bf16*)(P.ws + WS_XB))

#ifdef REPP
    PH_BEGIN p0_prologue(F, pk_); __syncthreads(); p0_prologue(F, pk_); PH_END
#else
    PH_BEGIN p0_prologue(F, pk_); PH_END
#endif

#pragma unroll 1
    for (int l = 0; l < 2; ++l) {
        PH_BEGIN if (l == 0) norm_mod_phase<true, false>(F, P.x, P.norm_ffn1 + l * DM, modl, 0, 1, H); else norm_mod_phase<true, true>(F, XB, P.norm_ffn1 + l * DM, modl, 0, 1, H); PH_END
        PH_BEGIN { pg8::Gemm g{H, (const bf16*)(wl + OFF_WGU1), MTOK, NGU, DM / 2}; pg8::StaticOrder S; S.init(MTOK, NGU, F.G, F.bid);
                   pg8::EpiSwiGLU<true> E{ACT, DFF}; pg8::gemm_phase<pg8::EpiSwiGLU<true>, pg8::StaticOrder, true, true, true>(F.lds, g, S, E, F.wave); } PH_END
        PH_BEGIN { pg8::Gemm g{ACT, (const bf16*)(wl + OFF_WD1), MTOK, DM, DFF / 2}; pg8::StaticOrder S; S.init(MTOK, DM, F.G, F.bid);
                   if (l == 0) { pg8::EpiResid<false, true> E{P.x, XB, modl, 2, 0.5f}; pg8::gemm_phase<pg8::EpiResid<false, true>, pg8::StaticOrder, true, true, true>(F.lds, g, S, E, F.wave); }
                   else { pg8::EpiResid<true, true> E{XB, XB, modl, 2, 0.5f}; pg8::gemm_phase<pg8::EpiResid<true, true>, pg8::StaticOrder, true, true, true>(F.lds, g, S, E, F.wave); } } PH_END
        PH_BEGIN norm_mod_phase<false, true>(F, XB, P.norm_mix + l * DM, modl, 3, 4, H); PH_END
        PH_BEGIN { pg8::Gemm g{H, (const bf16*)(wl + OFF_WIN), MTOK, NPROJ, DM}; pg8::StaticOrder S; S.init(MTOK, NPROJ, F.G, F.bid);
                   pg8::EpiProj E{QBUF, KVB, WI32, P.qn_a + l * 64, P.kn_a + l * 64, P.qn_c + l * 64, P.kn_c + l * 64, QSCALE};
                   pg8::gemm_phase<pg8::EpiProj, pg8::StaticOrder, true, true>(F.lds, g, S, E, F.wave); } PH_END
        PH_BEGIN {
            idx_phase(F, QBUF, KVB, WI32, MASKW, pt_acc, pt_t0);
            PT_START(13);
            unsigned* qctr = (unsigned*)(P.ws + WS_CTL) + 3072 + 64 * l;
            volatile LAS unsigned* qslot = MISC + 16;
            for (;;) {
                __syncthreads();
                if (F.tid == 0) *qslot = __hip_atomic_fetch_add(qctr, 1u, __ATOMIC_RELAXED, __HIP_MEMORY_SCOPE_AGENT);
                __syncthreads();
                const unsigned item = *qslot;
                if (item >= 1024u) break;
                if (item < 512u) { const int u = (int)item, bh = u >> 3, h = bh & 7; const int idx = 3 * (h >> 1) + (h & 1);
                    PT_START(14);
#ifdef REPC
                    att::attC_unit(bh >> 3, h, u & 7, QBUF, KVB, OB, F.lds, exp2f(-(2.0f / 3.0f) * (float)(idx + 1)) * LOG2E, F.wave); __syncthreads();
#endif
                    att::attC_unit(bh >> 3, h, u & 7, QBUF, KVB, OB, F.lds, exp2f(-(2.0f / 3.0f) * (float)(idx + 1)) * LOG2E, F.wave); if (pt_acc == 0) PT_STOP(14); }
                else { const int u = (int)item - 512, bh = u >> 4; PT_START(15);
#ifdef REPB
                    att::attB_unit(bh >> 2, bh & 3, u & 15, QBUF, KVB, OB, F.lds, F.wave); __syncthreads();
#endif
                    att::attB_unit(bh >> 2, bh & 3, u & 15, QBUF, KVB, OB, F.lds, F.wave); if (pt_acc == 0) PT_STOP(15); }
            }
            PT_STOP(13);
        } PH_END
        PH_BEGIN {
            PT_START(11);
            for (int p = F.vcu; p < 256; p += F.G) { const int bh = p >> 3, b = bh >> 2, h = bh & 3, s = p & 7; const float slope2 = exp2f(-(float)(2 * h + 2)) * LOG2E;
                att::attA_unit_s(b, h, s, QBUF, KVB, MASKW, OB, F.lds, slope2, F.wave); att::attA_unit_s(b, h, 15 - s, QBUF, KVB, MASKW, OB, F.lds, slope2, F.wave); }
            PT_STOP(11);
        } PH_END
        PH_BEGIN group_norm_phase(F, OB, (unsigned char*)QBUF); PH_END
        PH_BEGIN { pg8::Gemm g{(const bf16*)QBUF, (const bf16*)(wl + OFF_WOUT), MTOK, DM, DM / 2}; pg8::StaticOrder S; S.init(MTOK, DM, F.G, F.bid);
                   pg8::EpiResid<true, true> E{XB, XB, modl, 5, 1.0f}; pg8::gemm_phase<pg8::EpiResid<true, true>, pg8::StaticOrder, true, true, true>(F.lds, g, S, E, F.wave); } PH_END
        PH_BEGIN norm_mod_phase<true, true>(F, XB, P.norm_ffn2 + l * DM, modl, 6, 7, H); PH_END
        PH_BEGIN { pg8::Gemm g{H, (const bf16*)(wl + OFF_WGU2), MTOK, NGU, DM / 2}; pg8::StaticOrder S; S.init(MTOK, NGU, F.G, F.bid);
                   pg8::EpiSwiGLU<true> E{ACT, DFF}; pg8::gemm_phase<pg8::EpiSwiGLU<true>, pg8::StaticOrder, true, true, true>(F.lds, g, S, E, F.wave); } PH_END
        PH_BEGIN { pg8::Gemm g{ACT, (const bf16*)(wl + OFF_WD2), MTOK, DM, DFF / 2}; pg8::StaticOrder S; S.init(MTOK, DM, F.G, F.bid);
                   if (l == 1) { pg8::EpiResid<true, false> E{XB, P.out, modl, 8, 0.5f}; pg8::gemm_phase<pg8::EpiResid<true, false>, pg8::StaticOrder, true, true, true>(F.lds, g, S, E, F.wave); }
                   else { pg8::EpiResid<true, true> E{XB, XB, modl, 8, 0.5f}; pg8::gemm_phase<pg8::EpiResid<true, true>, pg8::StaticOrder, true, true, true>(F.lds, g, S, E, F.wave); } } PH_END
    }
#if PROBE_T || defined(ITER_PROBE)
    {   KargPtr pk_ = (KargPtr)__builtin_amdgcn_kernarg_segment_ptr(); asm volatile("" : "+s"(pk_));
        unsigned* ctlp = (unsigned*)(P.ws + WS_CTL);
        if (F.bid == PROBE_BLK && F.tid == 0) __hip_atomic_store(ctlp + 2048, (unsigned)(pt_acc >> 4), __ATOMIC_RELAXED, __HIP_MEMORY_SCOPE_AGENT);
        { XcdBarrier b2_; b2_.bar = ctlp + CW_BAR; b2_.x = xb_xcc_id(); b2_.st = MISC + 8; b2_.t0 = (F.tid == 0); xcd_barrier(b2_); }
#ifdef ITER_PROBE
        const float sc = 1.0f + (float)__hip_atomic_load(ctlp + 2064, __ATOMIC_RELAXED, __HIP_MEMORY_SCOPE_AGENT) / (2.0f * 8.0f * 240.0f * 8.0f);
#else
        const float cyc = 16.0f * (float)__hip_atomic_load(ctlp + 2048, __ATOMIC_RELAXED, __HIP_MEMORY_SCOPE_AGENT);
        const float sc = 1.0f + 10.0f * ((rintf(4.0f * log2f(fmaxf(cyc, 1024.0f)) + PROBE_SHIFT) - PROBE_SHIFT) * 0.25f - 10.0f);
#endif
        for (size_t i = (size_t)F.bid * NWAVES * 64 + F.tid; i < (size_t)MTOK * DM; i += (size_t)F.G * NWAVES * 64) P.out[i] *= sc;
    }
#endif
#undef PH_BEGIN
#undef PH_END
#undef P
#undef H
#undef QBUF
#undef KVB
#undef WI32
#undef ACT
#undef OB
#undef MASKW
#undef wl
#undef modl
#undef XB
}

extern "C" void kernel_launch(void* const* d_in, const int* in_sizes, int n_in, void* d_out, int out_size, void* d_ws, size_t ws_size, hipStream_t stream) {
    static int grid = 0;
    if (grid == 0) {
        if (n_in != 20 || in_sizes[0] != MTOK * DM || out_size != MTOK * DM || ws_size < WS_END) { fprintf(stderr, "kernel_launch: unexpected shapes (n_in %d, in0 %d, out %d, ws %zu); nothing launched\n", n_in, n_in > 0 ? in_sizes[0] : -1, out_size, ws_size); grid = -1; return; }
        int dev = 0, cus = 0, per_cu = 0;
        if (hipGetDevice(&dev) != hipSuccess || hipDeviceGetAttribute(&cus, hipDeviceAttributeMultiprocessorCount, dev) != hipSuccess) { grid = -1; return; }
        if (hipFuncSetAttribute((const void*)fwd_kernel, hipFuncAttributeMaxDynamicSharedMemorySize, LDS_BYTES) != hipSuccess) { fprintf(stderr, "kernel_launch: hipFuncSetAttribute failed\n"); grid = -1; return; }
        if (hipOccupancyMaxActiveBlocksPerMultiprocessor(&per_cu, (const void*)fwd_kernel, NWAVES * 64, LDS_BYTES) != hipSuccess || per_cu < 1)
            fprintf(stderr, "kernel_launch: note: occupancy query reports %d workgroups per CU\n", per_cu);
        (void)hipGetLastError();
        grid = cus;
    }
    if (grid < 0) return;
    if (hipMemsetAsync((char*)d_ws + WS_CTL, 0, CTL_ZERO_BYTES, stream) != hipSuccess) return;
    Ptrs a{};
    const float** pp = (const float**)&a;
    for (int i = 0; i < 20; ++i) pp[i] = (const float*)d_in[i];
    a.out = (float*)d_out; a.ws = (unsigned char*)d_ws;
#if MK_SPLIT
    for (int k = 0; k < N_PHASES; ++k) { a.ph_lo = k; a.ph_hi = k + 1; hipLaunchKernelGGL(fwd_kernel, dim3(grid), dim3(NWAVES * 64), LDS_BYTES, stream, a); }
#else
    a.ph_lo = 0; a.ph_hi = N_PHASES;
    hipLaunchKernelGGL(fwd_kernel, dim3(grid), dim3(NWAVES * 64), LDS_BYTES, stream, a);
#endif
    const hipError_t le = hipPeekAtLastError();
    if (le != hipSuccess) fprintf(stderr, "kernel_launch: launch failed: %s\n", hipGetErrorName(le));
}
```
